# Optimizing an MI355X kernel written in HIP

```python
import math
import jax, jax.numpy as jnp
from jax import lax
import numpy as np

D_MODEL = 4096
BATCH = 4
SEQ = 2048
DEPTH = 1

D_FF = 11008
ATTN_HEAD_DIM = 128
N_ATTN_HEADS = D_MODEL // (2 * ATTN_HEAD_DIM)
D_ATTN = N_ATTN_HEADS * ATTN_HEAD_DIM
DILATED_CONFIGS = ((128, 1), (512, 4), (2048, 16))
ATTN_BLOCK = 128
DN_HEAD_DIM = 128
N_DN_HEADS = D_MODEL // (2 * DN_HEAD_DIM)
D_DN = N_DN_HEADS * DN_HEAD_DIM
CONV_WIDTH = 4
CHUNK = 64
D_MIX = D_ATTN + D_DN
IN_SPLITS = (D_ATTN, D_ATTN, D_ATTN, 3 * D_DN, D_DN, N_DN_HEADS, N_DN_HEADS)
D_IN_PROJ = sum(IN_SPLITS)
EPS = 1e-6

kernel_name = "hymba_dilated_swa_gated_deltanet_macaron"


def _rmsnorm(x, w):
    xf = x.astype(jnp.float32)
    y = xf * lax.rsqrt(jnp.mean(xf * xf, axis=-1, keepdims=True) + EPS)
    return (y * w.astype(jnp.float32)).astype(x.dtype)


def _swiglu(h, w_gate, w_up, w_down):
    return (jax.nn.silu(h @ w_gate) * (h @ w_up)) @ w_down


def _band_attention(q, k, v, steps):
    G, L, H, Dh = q.shape
    nb = -(-L // ATTN_BLOCK)
    lp = nb * ATTN_BLOCK
    qb = jnp.pad(q, ((0, 0), (0, lp - L), (0, 0), (0, 0))).reshape(G, nb, ATTN_BLOCK, H, Dh)

    def band(t):
        t = jnp.pad(t, ((0, 0), (ATTN_BLOCK, lp - L), (0, 0), (0, 0)))
        t = t.reshape(G, nb + 1, ATTN_BLOCK, H, Dh)
        return jnp.concatenate([t[:, :-1], t[:, 1:]], axis=2)

    kw, vw = band(k), band(v)
    s = jnp.einsum('gnqhd,gnkhd->gnhqk', qb, kw, preferred_element_type=jnp.float32) * (Dh ** -0.5)
    i = jnp.arange(ATTN_BLOCK)[:, None]
    j = jnp.arange(2 * ATTN_BLOCK)[None, :]
    dist = i + ATTN_BLOCK - j
    kpos = jnp.arange(nb)[:, None, None] * ATTN_BLOCK - ATTN_BLOCK + j
    valid = (dist >= 0) & (dist <= steps) & (kpos >= 0)
    s = jnp.where(valid[:, None], s, -jnp.inf)
    m = jnp.max(s, axis=-1, keepdims=True)
    p = jnp.exp(s - m)
    den = jnp.sum(p, axis=-1)
    num = jnp.einsum('gnhqk,gnkhd->gnqhd', p, vw.astype(jnp.float32))
    m = m[..., 0].transpose(0, 1, 3, 2).reshape(G, lp, H)[:, :L]
    den = den.transpose(0, 1, 3, 2).reshape(G, lp, H)[:, :L]
    num = num.reshape(G, lp, H, Dh)[:, :L]
    return m, num, den


def _dilated_attention(q, k, v):
    B, S, H, Dh = q.shape
    ms, nums, dens = [], [], []
    for window, d in DILATED_CONFIGS:
        L = S // d

        def to_res(t):
            return t.reshape(B, L, d, H, Dh).transpose(0, 2, 1, 3, 4).reshape(B * d, L, H, Dh)

        def from_res(t):
            rest = t.shape[2:]
            return jnp.swapaxes(t.reshape(B, d, L, *rest), 1, 2).reshape(B, S, *rest)

        m, num, den = _band_attention(to_res(q), to_res(k), to_res(v), window // d)
        ms.append(from_res(m)); nums.append(from_res(num)); dens.append(from_res(den))
    m_all = jnp.stack(ms)
    w = jnp.exp(m_all - jnp.max(m_all, axis=0, keepdims=True))
    num = jnp.sum(w[..., None] * jnp.stack(nums), axis=0)
    den = jnp.sum(w * jnp.stack(dens), axis=0)
    return num / den[..., None]


def _causal_conv(x, w):
    S = x.shape[1]
    xp = jnp.pad(x, ((0, 0), (CONV_WIDTH - 1, 0), (0, 0)))
    return sum(w[i] * xp[:, i:i + S] for i in range(CONV_WIDTH))


def _gated_delta_rule(q, k, v, g, beta):
    B, S, H, Dk = q.shape
    Dv = v.shape[-1]
    N = S // CHUNK

    def chunks(t):
        return jnp.swapaxes(t.reshape(B, N, CHUNK, H, *t.shape[3:]), 2, 3)

    q, k, v, g, beta = (chunks(t.astype(jnp.float32)) for t in (q, k, v, g, beta))
    gc = jnp.cumsum(g, axis=-1)
    idx = jnp.arange(CHUNK)
    incl = idx[:, None] >= idx[None, :]
    strict = idx[:, None] > idx[None, :]
    decay = jnp.exp(jnp.where(incl, gc[..., :, None] - gc[..., None, :], -jnp.inf))
    kb = k * beta[..., None]
    kk = jnp.einsum('bnhid,bnhjd->bnhij', kb, k)
    a = jnp.where(strict, kk * decay, 0.0) + jnp.eye(CHUNK, dtype=jnp.float32)
    rhs = jnp.concatenate([kb * jnp.exp(gc)[..., None], v * beta[..., None]], axis=-1)
    sol = lax.linalg.triangular_solve(a, rhs, left_side=True, lower=True, unit_diagonal=True)
    w_c, u_c = sol[..., :Dk], sol[..., Dk:]
    qk = jnp.einsum('bnhid,bnhjd->bnhij', q, k) * decay
    q_dec = q * jnp.exp(gc)[..., None]
    k_dec = k * jnp.exp(gc[..., -1:] - gc)[..., None]
    g_last = jnp.exp(gc[..., -1])

    def step(state, xs):
        wc, uc, qkc, qdc, kdc, glc = xs
        v_new = uc - jnp.einsum('bhcd,bhdv->bhcv', wc, state)
        o = jnp.einsum('bhcd,bhdv->bhcv', qdc, state) + jnp.einsum('bhij,bhjv->bhiv', qkc, v_new)
        state = state * glc[..., None, None] + jnp.einsum('bhcd,bhcv->bhdv', kdc, v_new)
        return state, o

    xs = tuple(jnp.moveaxis(t, 1, 0) for t in (w_c, u_c, qk, q_dec, k_dec, g_last))
    state0 = jnp.zeros((B, H, Dk, Dv), jnp.float32)
    _, o = lax.scan(step, state0, xs)
    return o.transpose(1, 0, 3, 2, 4).reshape(B, S, H, Dv)


def _hybrid_mixer(h, w_in, conv_w, a_log, dt_bias, dn_norm, w_out):
    B, S, _ = h.shape
    proj = h @ w_in
    cuts = [int(c) for c in np.cumsum(IN_SPLITS)[:-1]]
    aq, ak, av, dqkv, dz, db, da = jnp.split(proj, cuts, axis=-1)
    heads_a = lambda t: t.reshape(B, S, N_ATTN_HEADS, ATTN_HEAD_DIM)
    attn = _dilated_attention(heads_a(aq), heads_a(ak), heads_a(av))
    attn = attn.reshape(B, S, D_ATTN).astype(h.dtype)
    dqkv = jax.nn.silu(_causal_conv(dqkv, conv_w))
    dq, dk, dv = jnp.split(dqkv, 3, axis=-1)
    heads_b = lambda t: t.reshape(B, S, N_DN_HEADS, DN_HEAD_DIM).astype(jnp.float32)
    dq, dk, dv = heads_b(dq), heads_b(dk), heads_b(dv)
    l2 = lambda t: t * lax.rsqrt(jnp.sum(t * t, axis=-1, keepdims=True) + EPS)
    dq = l2(dq) * (DN_HEAD_DIM ** -0.5)
    dk = l2(dk)
    beta = jax.nn.sigmoid(db.astype(jnp.float32))
    g = -jnp.exp(a_log.astype(jnp.float32)) * jax.nn.softplus(da.astype(jnp.float32) + dt_bias.astype(jnp.float32))
    o = _gated_delta_rule(dq, dk, dv, g, beta)
    o = o * lax.rsqrt(jnp.mean(o * o, axis=-1, keepdims=True) + EPS) * dn_norm.astype(jnp.float32)
    o = o * jax.nn.silu(heads_b(dz))
    dn = o.reshape(B, S, D_DN).astype(h.dtype)
    return jnp.concatenate([attn, dn], axis=-1) @ w_out


def setup_inputs(seed: int = 0) -> dict:
    key = jax.random.key(seed)
    ks = jax.random.split(key, 20)
    f32 = jnp.float32
    nrm = lambda k, shape, fan_in: jax.random.normal(k, shape, f32) * fan_in ** -0.5
    gain = lambda k, n: 1.0 + 0.05 * jax.random.normal(k, (n,), f32)
    dt = jnp.exp(jax.random.uniform(ks[9], (N_DN_HEADS,), f32, math.log(1e-3), math.log(1e-1)))
    return {
        "x": jax.random.normal(ks[0], (BATCH, SEQ, D_MODEL), f32),
        "ffn1_norm": gain(ks[1], D_MODEL),
        "ffn1_w_gate": nrm(ks[2], (D_MODEL, D_FF), D_MODEL),
        "ffn1_w_up": nrm(ks[3], (D_MODEL, D_FF), D_MODEL),
        "ffn1_w_down": nrm(ks[4], (D_FF, D_MODEL), D_FF),
        "mix_norm": gain(ks[5], D_MODEL),
        "w_in": nrm(ks[6], (D_MODEL, D_IN_PROJ), D_MODEL),
        "conv_w": nrm(ks[7], (CONV_WIDTH, 3 * D_DN), CONV_WIDTH),
        "a_log": jnp.log(jax.random.uniform(ks[8], (N_DN_HEADS,), f32, 1.0, 16.0)),
        "dt_bias": dt + jnp.log(-jnp.expm1(-dt)),
        "dn_norm": gain(ks[10], DN_HEAD_DIM),
        "w_out": nrm(ks[11], (D_MIX, D_MODEL), D_MIX),
        "ffn2_norm": gain(ks[12], D_MODEL),
        "ffn2_w_gate": nrm(ks[13], (D_MODEL, D_FF), D_MODEL),
        "ffn2_w_up": nrm(ks[14], (D_MODEL, D_FF), D_MODEL),
        "ffn2_w_down": nrm(ks[15], (D_FF, D_MODEL), D_FF),
        "final_norm": gain(ks[16], D_MODEL),
    }


def reference(x, ffn1_norm, ffn1_w_gate, ffn1_w_up, ffn1_w_down, mix_norm, w_in, conv_w,
              a_log, dt_bias, dn_norm, w_out, ffn2_norm, ffn2_w_gate, ffn2_w_up, ffn2_w_down,
              final_norm):
    h = x
    for _ in range(DEPTH):
        h = h + 0.5 * _swiglu(_rmsnorm(h, ffn1_norm), ffn1_w_gate, ffn1_w_up, ffn1_w_down)
        h = h + _hybrid_mixer(_rmsnorm(h, mix_norm), w_in, conv_w, a_log, dt_bias, dn_norm, w_out)
        h = h + 0.5 * _swiglu(_rmsnorm(h, ffn2_norm), ffn2_w_gate, ffn2_w_up, ffn2_w_down)
    return _rmsnorm(h, final_norm)
```

```cpp
#include <hip/hip_runtime.h>
#include <cstdio>
#include <cstdint>

#ifndef ONE_LAUNCH
#define ONE_LAUNCH 1
#endif
#ifndef PROBE_X
#define PROBE_X 0
#endif
#ifndef PROBE_RESETQ
#define PROBE_RESETQ 0
#endif
#ifndef PROBE_REP
#define PROBE_REP -1
#endif

constexpr int M = 8192, SEQ = 2048, D = 4096, FF = 11008, NPROJ = 14368, NPROJ_MAIN = 14336, NH = 16, HD = 128;
constexpr int PJ_Q = 0, PJ_K = 2048, PJ_V = 4096, PJ_DQKV = 6144, PJ_DZ = 12288;
constexpr int LDD = D + 64, LDF = FF + 64, LDP = NPROJ_MAIN + 64;
constexpr float FIXS = 16777216.0f;
constexpr float EPS = 1e-6f;

__device__ __forceinline__ int fresh_lane() { int l; asm volatile("v_mbcnt_lo_u32_b32 %0, -1, 0\n\tv_mbcnt_hi_u32_b32 %0, -1, %0" : "=v"(l)); return l; }

namespace pg8 {
#define PG8_LAS __attribute__((address_space(3)))
typedef unsigned short bf16_t;
typedef short bf16x8 __attribute__((ext_vector_type(8)));
typedef float f32x4 __attribute__((ext_vector_type(4)));
typedef unsigned u32x4 __attribute__((ext_vector_type(4)));
constexpr int BM = 256, BK = 64, HALF = 128, HTB = HALF * BK * 2  , STAGE_BYTES = 8 * HTB, NXCD = 8, WGM = 8;

__host__ __device__ __forceinline__ int lds_byte(int r, int c) { const int st = (r >> 4) * 2 + (c >> 5), rr = r & 15, cc = c & 31, ob = rr * 64 + cc * 2; return st * 1024 + (ob ^ (((ob >> 9) & 1) << 5)); }
__host__ __device__ __forceinline__ void stage_rc(int b, int& R, int& C) { const int st = b / 1024, sb = b % 1024, swz = sb ^ (((sb >> 9) & 1) << 5); R = (st >> 1) * 16 + swz / 64; C = (st & 1) * 32 + (swz % 64) / 2; }
__host__ __device__ __forceinline__ int perm32(int rho) { const int n = rho >> 4, i = rho & 15; return 8 * (i >> 2) + 4 * n + (i & 3); }

struct Unit { int pm, pn; };
struct Gemm { const bf16_t* A; const bf16_t* Bt; int M, N, K, lda, ldb; };

struct StaticOrder {
    int nM, nN, nwg, G, c;
    __host__ __device__ void init(int M, int N, int G_, int c_) { nM = M / BM; nN = N / BM; nwg = nM * nN; G = G_; c = c_; }
    __host__ __device__ bool next(int i, Unit& u) const {
        const long L = (long)i * G + c; if (L >= nwg) return false;
        int wgid = (int)L; { const int q = nwg / NXCD, r = nwg % NXCD, xcd = wgid % NXCD, off = wgid / NXCD; wgid = (xcd < r ? xcd * (q + 1) : r * (q + 1) + (xcd - r) * q) + off; }
        const int nig = WGM * nN, gid = wgid / nig, fm = gid * WGM, gsz = (nM - fm) < WGM ? (nM - fm) : WGM;
        u.pm = fm + ((wgid % nig) % gsz); u.pn = (wgid % nig) / gsz; return true;
    }
    __device__ __forceinline__ void a_ready(const Unit&) const {}
    __device__ __forceinline__ void done(const Unit&) const {}
};

__device__ __forceinline__ unsigned cvt_pk_bf16(float lo, float hi) { unsigned r; asm volatile("v_cvt_pk_bf16_f32 %0, %1, %2" : "=v"(r) : "v"(lo), "v"(hi)); return r; }
typedef float f32x2 __attribute__((ext_vector_type(2)));

__device__ __forceinline__ float rstd_of(const unsigned long long* ssq, int row) {
    const unsigned long long q = ssq[row];
    const float s = (float)q * (1.0f / FIXS);
    return rsqrtf(s * (1.0f / (float)D) + EPS);
}
__device__ __forceinline__ float silu_f(float x) { return x * __builtin_amdgcn_rcpf(1.0f + __expf(-x)); }

struct EpiGateUp {
    static constexpr bool PERM = true, AFTER_DRAIN = false;
    bf16_t* O; const unsigned long long* ssq;
    __device__ __forceinline__ void operator()(const f32x4 (&acc)[2][2][4][2], const Unit& u, int wr, int wc, int fr, int fq) const {
        const int row0 = u.pm * BM + wr * 64 + fr, col0 = u.pn * HALF + wc * 32 + 8 * fq;
#pragma unroll
        for (int ai = 0; ai < 2; ++ai)
#pragma unroll
            for (int m = 0; m < 4; ++m) {
                const int row = row0 + ai * HALF + m * 16; const float rs = rstd_of(ssq, row);
                const f32x4 g0 = acc[ai][0][m][0] * rs, g1 = acc[ai][0][m][1] * rs, u0 = acc[ai][1][m][0] * rs, u1 = acc[ai][1][m][1] * rs;
                u32x4 w;
                w.x = cvt_pk_bf16(silu_f(g0[0]) * u0[0], silu_f(g0[1]) * u0[1]); w.y = cvt_pk_bf16(silu_f(g0[2]) * u0[2], silu_f(g0[3]) * u0[3]);
                w.z = cvt_pk_bf16(silu_f(g1[0]) * u1[0], silu_f(g1[1]) * u1[1]); w.w = cvt_pk_bf16(silu_f(g1[2]) * u1[2], silu_f(g1[3]) * u1[3]);
                *(u32x4*)(O + (size_t)row * LDF + col0) = w;
            }
    }
};
template <bool WRITE_XB, bool WRITE_F32 = true> struct EpiResid {
    static constexpr bool PERM = true, AFTER_DRAIN = false;
    const float* R; float* Of; bf16_t* XB; unsigned long long* ssq; float scale;
    __device__ __forceinline__ void operator()(const f32x4 (&acc)[2][2][4][2], const Unit& u, int wr, int wc, int fr, int fq) const {
        const int row0 = u.pm * BM + wr * 64 + fr, col0 = u.pn * BM + wc * 32 + 8 * fq;
#pragma unroll
        for (int ai = 0; ai < 2; ++ai)
#pragma unroll
            for (int m = 0; m < 4; ++m) {
                const int row = row0 + ai * HALF + m * 16; const size_t off = (size_t)row * D + col0; float ss = 0.f;
#pragma unroll
                for (int bj = 0; bj < 2; ++bj) {
                    const f32x4 r0 = *(const f32x4*)(R + off + bj * HALF), r1 = *(const f32x4*)(R + off + bj * HALF + 4);
                    const f32x4 h0 = r0 + acc[ai][bj][m][0] * scale, h1 = r1 + acc[ai][bj][m][1] * scale;
                    if (WRITE_F32) { *(f32x4*)(Of + off + bj * HALF) = h0; *(f32x4*)(Of + off + bj * HALF + 4) = h1; }
                    if (WRITE_XB) { u32x4 w; w.x = cvt_pk_bf16(h0[0], h0[1]); w.y = cvt_pk_bf16(h0[2], h0[3]); w.z = cvt_pk_bf16(h1[0], h1[1]); w.w = cvt_pk_bf16(h1[2], h1[3]);
                        *(u32x4*)(XB + (size_t)row * LDD + col0 + bj * HALF) = w; }
                    ss += (h0[0] * h0[0] + h0[1] * h0[1]) + (h0[2] * h0[2] + h0[3] * h0[3]) + (h1[0] * h1[0] + h1[1] * h1[1]) + (h1[2] * h1[2] + h1[3] * h1[3]);
                }
                ss += __shfl_xor(ss, 16); ss += __shfl_xor(ss, 32);
                if (fq == 0) __hip_atomic_fetch_add(ssq + row, (unsigned long long)(ss * FIXS), __ATOMIC_RELAXED, __HIP_MEMORY_SCOPE_AGENT);
                asm volatile("" ::: "memory");
            }
    }
};
struct EpiProj {
    static constexpr bool PERM = true, AFTER_DRAIN = false;
    bf16_t* O; const unsigned long long* ssq;
    __device__ __forceinline__ void operator()(const f32x4 (&acc)[2][2][4][2], const Unit& u, int wr, int wc, int fr, int fq) const {
        const int row0 = u.pm * BM + wr * 64 + fr, col0 = u.pn * BM + wc * 32 + 8 * fq;
#pragma unroll
        for (int ai = 0; ai < 2; ++ai)
#pragma unroll
            for (int m = 0; m < 4; ++m) {
                const int row = row0 + ai * HALF + m * 16; const float rs = rstd_of(ssq, row);
#pragma unroll
                for (int bj = 0; bj < 2; ++bj) { const f32x4 v0 = acc[ai][bj][m][0] * rs, v1 = acc[ai][bj][m][1] * rs;
                    u32x4 w; w.x = cvt_pk_bf16(v0[0], v0[1]); w.y = cvt_pk_bf16(v0[2], v0[3]); w.z = cvt_pk_bf16(v1[0], v1[1]); w.w = cvt_pk_bf16(v1[2], v1[3]);
                    *(u32x4*)(O + (size_t)row * LDP + col0 + bj * HALF) = w; }
            }
    }
};

struct EpiNull {
    static constexpr bool PERM = true, AFTER_DRAIN = false;
    float* sink;
    __device__ __forceinline__ void operator()(const f32x4 (&acc)[2][2][4][2], const Unit& u, int wr, int wc, int fr, int fq) const {
        float s = 0.f;
#pragma unroll
        for (int ai = 0; ai < 2; ++ai)
#pragma unroll
            for (int bj = 0; bj < 2; ++bj)
#pragma unroll
                for (int m = 0; m < 4; ++m)
#pragma unroll
                    for (int n = 0; n < 2; ++n) s += (acc[ai][bj][m][n][0] + acc[ai][bj][m][n][1]) + (acc[ai][bj][m][n][2] + acc[ai][bj][m][n][3]);
        if (s == 123456.789f) sink[u.pm * 64 + fr] = s;
    }
};
struct MaskOrder : StaticOrder {
    int mm, mn;
    __host__ __device__ bool next(int i, Unit& u) const { const bool ok = StaticOrder::next(i, u); u.pm &= mm; u.pn &= mn; return ok; }
};

#ifndef PG8_B_AUX
#define PG8_B_AUX 0
#endif
template <class Epi, class Sched, bool ALIGN_EPI = false, bool SP2 = false>
__device__ __forceinline__ void gemm_phase(PG8_LAS unsigned char* lds, const Gemm g, const Sched& S, const Epi& E, int wid) {
    const int lane = fresh_lane(), tid = wid * 64 + lane, wr = wid >> 2, wc = wid & 3, fr = lane & 15, fq = lane >> 4;
    const int K = g.K, nt = K / BK;
    unsigned voffA[2], voffB[2];
#pragma unroll
    for (int i = 0; i < 2; ++i) { int R, C; stage_rc(tid * 16 + i * 8192, R, C); const int Rb = Epi::PERM ? ((R & ~31) + perm32(R & 31)) : R;
        voffA[i] = (unsigned)(R * g.lda + C) * 2u; voffB[i] = (unsigned)(Rb * g.ldb + C) * 2u; }
    const size_t kstep = (size_t)(BK * 2);
    const size_t hstepA = (size_t)HALF * g.lda * 2, hstepB = (size_t)HALF * g.ldb * 2;
    const size_t tstepA = 2 * hstepA, tstepB = 2 * hstepB;
    const unsigned ldsw = (unsigned)wid * 1024u;
    const int aoff = lds_byte(wr * 64 + fr, fq * 8), boff = lds_byte(wc * 32 + fr, fq * 8);
#define PG8_SA(b, h) (((b) * 2 + (h)) * HTB)
#define PG8_SB(b, h) ((4 + (b) * 2 + (h)) * HTB)
#define PG8_STAGE(bufoff, gbase, voff) do { _Pragma("unroll") for (int _i = 0; _i < 2; ++_i) \
        __builtin_amdgcn_global_load_lds((const unsigned*)((const char*)(gbase) + (voff)[_i]), (PG8_LAS unsigned*)(lds + (bufoff) + ldsw + _i * 8192), 16, 0, 0); } while (0)
#define PG8_STAGE_NT(bufoff, gbase, voff) do { _Pragma("unroll") for (int _i = 0; _i < 2; ++_i) \
        __builtin_amdgcn_global_load_lds((const unsigned*)((const char*)(gbase) + (voff)[_i]), (PG8_LAS unsigned*)(lds + (bufoff) + ldsw + _i * 8192), 16, 0, PG8_B_AUX); } while (0)
#define PG8_LDA(dst, b, h) do { _Pragma("unroll") for (int m = 0; m < 4; ++m) _Pragma("unroll") for (int k = 0; k < 2; ++k) dst[m][k] = *(const PG8_LAS bf16x8*)(lds + PG8_SA(b, h) + aoff + m * 2048 + k * 1024); } while (0)
#define PG8_LDB(dst, b, h) do { _Pragma("unroll") for (int n = 0; n < 2; ++n) _Pragma("unroll") for (int k = 0; k < 2; ++k) dst[n][k] = *(const PG8_LAS bf16x8*)(lds + PG8_SB(b, h) + boff + n * 2048 + k * 1024); } while (0)
#define PG8_MMA(ai, bj, At, Bt) do { __builtin_amdgcn_s_setprio(1); _Pragma("unroll") for (int m = 0; m < 4; ++m) _Pragma("unroll") for (int n = 0; n < 2; ++n) _Pragma("unroll") for (int k = 0; k < 2; ++k) \
        acc[ai][bj][m][n] = __builtin_amdgcn_mfma_f32_16x16x32_bf16(Bt[n][k], At[m][k], acc[ai][bj][m][n], 0, 0, 0); __builtin_amdgcn_s_setprio(0); } while (0)
#define PG8_WAIT_V(n) asm volatile("s_waitcnt vmcnt(" #n ")" ::: "memory")
#define PG8_WAIT_L(n) asm volatile("s_waitcnt lgkmcnt(" #n ")" ::: "memory")
#define PG8_BAR __builtin_amdgcn_s_barrier()
#define PG8_SCHED __builtin_amdgcn_sched_barrier(0)
    Unit cur, nxt; int ui = 0;
    if (!S.next(0, cur)) return;
    f32x4 acc[2][2][4][2];
#pragma unroll
    for (int a = 0; a < 2; ++a)
#pragma unroll
        for (int b = 0; b < 2; ++b)
#pragma unroll
            for (int m = 0; m < 4; ++m)
#pragma unroll
                for (int n = 0; n < 2; ++n) acc[a][b][m][n] = (f32x4){0.f, 0.f, 0.f, 0.f};
    bf16x8 At[4][2], B0[2][2], B1[2][2];
    const char* cA = (const char*)g.A + (size_t)cur.pm * tstepA; const char* cB = (const char*)g.Bt + (size_t)cur.pn * tstepB;
    S.a_ready(cur);
    if constexpr (SP2) {
        PG8_STAGE_NT(PG8_SB(0, 0), cB, voffB); PG8_STAGE_NT(PG8_SB(0, 1), cB + hstepB, voffB); PG8_STAGE(PG8_SA(0, 0), cA, voffA); PG8_STAGE(PG8_SA(0, 1), cA + hstepA, voffA);
        if (wr == 1) PG8_BAR;
        PG8_WAIT_V(2); PG8_BAR;
        PG8_STAGE_NT(PG8_SB(1, 0), cB + kstep, voffB); PG8_STAGE(PG8_SA(1, 0), cA + kstep, voffA); PG8_STAGE_NT(PG8_SB(1, 1), cB + hstepB + kstep, voffB);
        PG8_WAIT_V(6); PG8_BAR;
    } else {
        PG8_STAGE_NT(PG8_SB(0, 0), cB, voffB); PG8_STAGE(PG8_SA(0, 0), cA, voffA); PG8_STAGE_NT(PG8_SB(0, 1), cB + hstepB, voffB); PG8_STAGE(PG8_SA(0, 1), cA + hstepA, voffA);
        if (wr == 1) PG8_BAR;
        PG8_WAIT_V(4); PG8_BAR;
        PG8_STAGE_NT(PG8_SB(1, 0), cB + kstep, voffB); PG8_STAGE(PG8_SA(1, 0), cA + kstep, voffA); PG8_STAGE_NT(PG8_SB(1, 1), cB + hstepB + kstep, voffB);
        PG8_WAIT_V(6); PG8_BAR;
    }
    for (;;) {
        const bool has_next = S.next(ui + 1, nxt);
        const char* nA = has_next ? (const char*)g.A + (size_t)nxt.pm * tstepA : cA; const char* nB = has_next ? (const char*)g.Bt + (size_t)nxt.pn * tstepB : cB;
        for (int t = 0; t < nt; t += 2) {
            const bool last = (t == nt - 2);
            const char* a1 = cA + (size_t)(t + 1) * kstep;
            const char* a2 = last ? nA : cA + (size_t)(t + 2) * kstep; const char* b2 = last ? nB : cB + (size_t)(t + 2) * kstep;
            const char* a3 = a2 + kstep; const char* b3 = b2 + kstep;
            if (last && has_next) S.a_ready(nxt);
            if constexpr (SP2) {
            PG8_LDB(B0, 0, 0); PG8_LDB(B1, 0, 1); PG8_SCHED; PG8_LDA(At, 0, 0); PG8_STAGE(PG8_SA(1, 1), a1 + hstepA, voffA);
            PG8_WAIT_V(8); PG8_WAIT_L(0); PG8_BAR; PG8_MMA(0, 0, At, B0); PG8_MMA(0, 1, At, B1); PG8_BAR; PG8_SCHED;
            PG8_LDA(At, 0, 1); PG8_STAGE_NT(PG8_SB(0, 0), b2, voffB); PG8_STAGE_NT(PG8_SB(0, 1), b2 + hstepB, voffB); PG8_STAGE(PG8_SA(0, 0), a2, voffA);
            PG8_WAIT_V(8); PG8_WAIT_L(0); PG8_BAR; PG8_MMA(1, 0, At, B0); PG8_MMA(1, 1, At, B1); PG8_BAR; PG8_SCHED;
            PG8_LDB(B0, 1, 0); PG8_LDB(B1, 1, 1); PG8_SCHED; PG8_LDA(At, 1, 0); PG8_STAGE(PG8_SA(0, 1), a2 + hstepA, voffA);
            PG8_WAIT_V(8); PG8_WAIT_L(0); PG8_BAR; PG8_MMA(0, 0, At, B0); PG8_MMA(0, 1, At, B1); PG8_BAR; PG8_SCHED;
            PG8_LDA(At, 1, 1); PG8_STAGE_NT(PG8_SB(1, 0), b3, voffB); PG8_STAGE_NT(PG8_SB(1, 1), b3 + hstepB, voffB); PG8_STAGE(PG8_SA(1, 0), a3, voffA);
            PG8_WAIT_V(8); PG8_WAIT_L(0); PG8_BAR; PG8_MMA(1, 0, At, B0); PG8_MMA(1, 1, At, B1); PG8_BAR; PG8_SCHED;
            } else {
            PG8_LDB(B0, 0, 0); PG8_SCHED; PG8_LDA(At, 0, 0); PG8_STAGE(PG8_SA(1, 1), a1 + hstepA, voffA);
            PG8_WAIT_L(8); PG8_BAR; PG8_WAIT_L(0); PG8_MMA(0, 0, At, B0); PG8_BAR; PG8_SCHED;
            PG8_LDB(B1, 0, 1); PG8_STAGE_NT(PG8_SB(0, 0), b2, voffB);
            PG8_BAR; PG8_WAIT_L(0); PG8_MMA(0, 1, At, B1); PG8_BAR;
            PG8_LDA(At, 0, 1); PG8_STAGE(PG8_SA(0, 0), a2, voffA);
            PG8_BAR; PG8_WAIT_L(0); PG8_MMA(1, 0, At, B0); PG8_BAR; PG8_SCHED;
            PG8_STAGE_NT(PG8_SB(0, 1), b2 + hstepB, voffB);
            PG8_WAIT_V(6); PG8_BAR; PG8_MMA(1, 1, At, B1); PG8_BAR;
            PG8_LDB(B0, 1, 0); PG8_SCHED; PG8_LDA(At, 1, 0); PG8_STAGE(PG8_SA(0, 1), a2 + hstepA, voffA);
            PG8_WAIT_L(8); PG8_BAR; PG8_WAIT_L(0); PG8_MMA(0, 0, At, B0); PG8_BAR; PG8_SCHED;
            PG8_LDB(B1, 1, 1); PG8_STAGE_NT(PG8_SB(1, 0), b3, voffB);
            PG8_BAR; PG8_WAIT_L(0); PG8_MMA(0, 1, At, B1); PG8_BAR;
            PG8_LDA(At, 1, 1); PG8_STAGE(PG8_SA(1, 0), a3, voffA);
            PG8_BAR; PG8_WAIT_L(0); PG8_MMA(1, 0, At, B0); PG8_BAR; PG8_SCHED;
            PG8_STAGE_NT(PG8_SB(1, 1), b3 + hstepB, voffB);
            PG8_WAIT_V(6); PG8_BAR; PG8_MMA(1, 1, At, B1); PG8_BAR;
            }
        }
        if constexpr (ALIGN_EPI) { if (wr == 0) PG8_BAR; }
        if constexpr (!Epi::AFTER_DRAIN) { E(acc, cur, wr, wc, fr, fq); S.done(cur); }
        if (!has_next) break;
#pragma unroll
        for (int a = 0; a < 2; ++a)
#pragma unroll
            for (int b = 0; b < 2; ++b)
#pragma unroll
                for (int m = 0; m < 4; ++m)
#pragma unroll
                    for (int n = 0; n < 2; ++n) acc[a][b][m][n] = (f32x4){0.f, 0.f, 0.f, 0.f};
        cur = nxt; cA = nA; cB = nB; ++ui;
        if constexpr (ALIGN_EPI) { if (wr == 1) PG8_BAR; }
    }
    PG8_WAIT_V(0);
    if constexpr (!ALIGN_EPI) { if (wr == 0) PG8_BAR; }
    PG8_BAR;
    if constexpr (Epi::AFTER_DRAIN) { E.fused(acc, cur, wr, wc, fr, fq, lds, wid, lane); S.done(cur); }
#undef PG8_SA
#undef PG8_SB
#undef PG8_STAGE
#undef PG8_STAGE_NT
#undef PG8_LDA
#undef PG8_LDB
#undef PG8_MMA
#undef PG8_WAIT_V
#undef PG8_WAIT_L
#undef PG8_BAR
#undef PG8_SCHED
}
}

constexpr size_t MiB = 1u << 20;
constexpr size_t WS_CTL = 0, CTL_ZERO_BYTES = 1 * MiB;
constexpr size_t WS_SSQ = 256 * 1024;
constexpr size_t WS_BETA = 2 * MiB, WS_G = WS_BETA + 512 * 1024, WS_GL = 3 * MiB;
constexpr size_t WS_WGU1 = 4 * MiB, WS_WD1 = WS_WGU1 + 176 * MiB, WS_WIN = WS_WD1 + 88 * MiB, WS_WOUT = WS_WIN + 115 * MiB, WS_WGU2 = WS_WOUT + 33 * MiB, WS_WD2 = WS_WGU2 + 176 * MiB;
constexpr size_t WS_XB = WS_WD2 + 88 * MiB;
constexpr size_t WS_ACT = WS_XB + 66 * MiB;
constexpr size_t WS_PROJ = WS_ACT + 174 * MiB;
constexpr size_t WS_CONCAT = WS_PROJ + 226 * MiB;
constexpr size_t WS_QN = WS_CONCAT + 66 * MiB, WS_KN = WS_QN + 32 * MiB, WS_VN = WS_KN + 32 * MiB;
constexpr size_t WS_ORAW = WS_VN + 32 * MiB;
constexpr size_t WS_END = WS_ORAW + 64 * MiB;
static_assert((size_t)2048 * 59904 <= 174 * MiB && (size_t)2 * FF * LDD * 2 <= 176 * MiB && (size_t)D * LDF * 2 <= 88 * MiB && (size_t)NPROJ * LDD * 2 <= 115 * MiB && (size_t)D * LDD * 2 <= 33 * MiB && (size_t)M * LDD * 2 <= 66 * MiB && (size_t)M * LDF * 2 <= 174 * MiB && (size_t)M * LDP * 2 <= 226 * MiB, "d_ws map");
constexpr int CW_BAR = 4096;
constexpr int CW_TQ = 8192 + 64, CW_DONE = 8192 + 128;
constexpr int CW_AQ = 8192;

constexpr int RING_BYTES = 131072;
constexpr int P0_SCR_BYTES = 8 * 64 * 65 * 4;
constexpr int LDSCTL_OFF = 163328, MISC_OFF = LDSCTL_OFF + 320;
constexpr int LDS_BYTES = 163840;
static_assert(P0_SCR_BYTES <= LDSCTL_OFF && MISC_OFF + 128 <= LDS_BYTES, "LDS map");

#define GAS __attribute__((address_space(1)))
#define LAS __attribute__((address_space(3)))
typedef unsigned short bf16;
typedef float f32x4 __attribute__((ext_vector_type(4)));
typedef float f32x2 __attribute__((ext_vector_type(2)));
typedef float f32x16 __attribute__((ext_vector_type(16)));
typedef unsigned u32x4 __attribute__((ext_vector_type(4)));
typedef unsigned u32x2 __attribute__((ext_vector_type(2)));
typedef short bf16x8 __attribute__((ext_vector_type(8)));
constexpr int NWAVES = 8;

__device__ __forceinline__ unsigned pk2(float lo, float hi) { return pg8::cvt_pk_bf16(lo, hi); }
__device__ __forceinline__ float bf_lo(unsigned w) { return __uint_as_float(w << 16); }
__device__ __forceinline__ float bf_hi(unsigned w) { return __uint_as_float(w & 0xffff0000u); }
__device__ __forceinline__ float bf2f(bf16 v) { return __uint_as_float(((unsigned)v) << 16); }
__device__ __forceinline__ float wave_sum(float v) {
#pragma unroll
    for (int o = 1; o < 64; o <<= 1) v += __shfl_xor(v, o);
    return v;
}
__device__ __forceinline__ float wave_max(float v) {
#pragma unroll
    for (int o = 1; o < 64; o <<= 1) v = fmaxf(v, __shfl_xor(v, o));
    return v;
}

#define XB_TMO      128
#define XB_XCNT(j)  (256  + 64 * (j))
#define XB_XSUB(j)  (1280 + 64 * (j))
#define XB_XGEN(j)  (2304 + 64 * (j))
#define XB_TOP      3328
#define XB_TOPGEN   3392
#define XCD_BAR_WORDS 3456
#define XB_SPIN_CAP (1u << 18)

__device__ __forceinline__ unsigned xb_ld(unsigned* p)              { return __hip_atomic_load(p, __ATOMIC_RELAXED, __HIP_MEMORY_SCOPE_AGENT); }
__device__ __forceinline__ unsigned xb_add(unsigned* p, unsigned v) { return __hip_atomic_fetch_add(p, v, __ATOMIC_RELAXED, __HIP_MEMORY_SCOPE_AGENT); }
__device__ __forceinline__ unsigned xb_xcc_id() { return (unsigned)__builtin_amdgcn_s_getreg((3 << 11) | 20) & 0xFu; }
#define XB_SPIN(cond, bar) do { unsigned _sp = 0; while (cond) { __builtin_amdgcn_s_sleep(1); \
    if ((++_sp & 255u) == 0u) { if (xb_ld(&(bar)[XB_TMO])) break; if (_sp > XB_SPIN_CAP) { atomicAdd(&(bar)[XB_TMO], 1u); break; } } } } while (0)

struct XcdBarrier {
    unsigned* bar; unsigned x;
    volatile LAS unsigned* st;
    int w;
};

__device__ __forceinline__ XcdBarrier xcd_barrier_post(unsigned* bar, volatile LAS unsigned* st) {
    XcdBarrier b; b.bar = bar; b.x = xb_xcc_id(); b.st = st;
    if (threadIdx.x == 0) (void)xb_add(&bar[XB_XCNT(b.x)], 1u);
    return b;
}
__device__ __forceinline__ void xcd_barrier_complete(unsigned* bar, unsigned x, unsigned& nloc, unsigned& nx) {
    const unsigned G = gridDim.x * gridDim.y * gridDim.z;
    unsigned sum, cnt, mine, sp = 0u;
    for (;;) {
        sum = 0u; cnt = 0u; mine = 0u;
#pragma unroll
        for (unsigned j = 0; j < 16; ++j) { const unsigned c = xb_ld(&bar[XB_XCNT(j)]); sum += c; cnt += (c > 0u) ? 1u : 0u; mine = (j == x) ? c : mine; }
        if (sum == G) break;
        __builtin_amdgcn_s_sleep(1);
        if ((++sp & 255u) == 0u) { if (xb_ld(&bar[XB_TMO])) break; if (sp > XB_SPIN_CAP) { atomicAdd(&bar[XB_TMO], 1u); break; } }
    }
    nloc = mine > 0u ? mine : 1u; nx = cnt > 0u ? cnt : 1u;
}

__device__ __forceinline__ void xcd_barrier(const XcdBarrier& b) {
    asm volatile("s_waitcnt vmcnt(0)" ::: "memory");
    __syncthreads();
    if (b.w == 0 && fresh_lane() == 0) {
        unsigned* bar = b.bar;
        __builtin_amdgcn_s_waitcnt(0);
        unsigned nloc = b.st[0], nx = b.st[1];
        if (nloc == 0u) { xcd_barrier_complete(bar, b.x, nloc, nx); b.st[0] = nloc; b.st[1] = nx; }
        const unsigned old = xb_add(&bar[XB_XSUB(b.x)], 1u);
        const unsigned gen = old / nloc;
        if (old + 1u == (gen + 1u) * nloc) {
            __builtin_amdgcn_fence(__ATOMIC_RELEASE, "agent");
            asm volatile("s_waitcnt vmcnt(0)" ::: "memory");
            const unsigned og = xb_add(&bar[XB_TOP], 1u);
            const unsigned tg = og / nx;
            if (og + 1u == (tg + 1u) * nx) xb_add(&bar[XB_TOPGEN], 1u);
            else XB_SPIN(xb_ld(&bar[XB_TOPGEN]) == tg, bar);
            __builtin_amdgcn_fence(__ATOMIC_ACQUIRE, "agent");
            xb_add(&bar[XB_XGEN(b.x)], 1u);
            asm volatile("s_waitcnt vmcnt(0)" ::: "memory");
        } else {
            XB_SPIN(xb_ld(&bar[XB_XGEN(b.x)]) == gen, bar);
            __builtin_amdgcn_fence(__ATOMIC_ACQUIRE, "agent");
            asm volatile("s_waitcnt vmcnt(0)" ::: "memory");
        }
    }
    __syncthreads();
}

#define P0T_DECL(x) const float* x##W = nullptr; const float* x##G = nullptr; bf16* x##T = nullptr; int x##K = 0, x##N = 0, x##k0 = 0, x##n0 = 0, x##ld = 0, x##blk = 0, x##off = 0
__device__ __forceinline__ void p0_load(const float* W, int N, int k0, int n0, int lane, f32x4 (&v)[16]) {
    const int c = lane & 15, rq = lane >> 4;
    int col = n0 + 4 * c; col = col < N - 4 ? col : N - 4;
    const float* p = W + (size_t)(k0 + rq) * N + col;
#pragma unroll
    for (int j = 0; j < 16; ++j) v[j] = __builtin_nontemporal_load((const f32x4*)(p + (size_t)(4 * j) * N));
}
__device__ __forceinline__ void p0_finish(bf16* WT, const float* gain, int N, int k0, int n0, int ldw, int blk, int off, int lane, const f32x4 (&v)[16], LAS float* scr) {
    const int c = lane & 15, rq = lane >> 4, c8 = lane & 7;
    f32x4 g0 = {1.f, 1.f, 1.f, 1.f}, g1 = g0;
    if (gain) { g0 = *(const f32x4*)(gain + k0 + 8 * c8); g1 = *(const f32x4*)(gain + k0 + 8 * c8 + 4); }
#pragma unroll
    for (int j = 0; j < 16; ++j) { LAS float* s = scr + (4 * j + rq) * 65 + 4 * c; s[0] = v[j][0]; s[1] = v[j][1]; s[2] = v[j][2]; s[3] = v[j][3]; }
    asm volatile("s_waitcnt lgkmcnt(0)" ::: "memory");
#pragma unroll
    for (int jj = 0; jj < 8; ++jj) { const int n = (lane >> 3) + 8 * jj; const LAS float* s = scr + (8 * c8) * 65 + n;
        u32x4 o; o.x = pk2(s[0 * 65] * g0[0], s[1 * 65] * g0[1]); o.y = pk2(s[2 * 65] * g0[2], s[3 * 65] * g0[3]); o.z = pk2(s[4 * 65] * g1[0], s[5 * 65] * g1[1]); o.w = pk2(s[6 * 65] * g1[2], s[7 * 65] * g1[3]);
        const int ng = n0 + n;
        if (ng < N) { const int row = (ng >> 7) * blk + (ng & 127) + off; __builtin_nontemporal_store(o, (u32x4*)(WT + (size_t)row * ldw + k0 + 8 * c8)); } }
    asm volatile("s_waitcnt lgkmcnt(0)" ::: "memory");
}

constexpr int ATT_KS_BYTES = 32 * 272, ATT_VS_BYTES = ATT_KS_BYTES + 32 * 320;
static_assert(8 * ATT_VS_BYTES <= LDSCTL_OFF, "attention LDS");
typedef short v4i16_t __attribute__((ext_vector_type(4)));
typedef __bf16 bf16x2_t __attribute__((ext_vector_type(2)));
__device__ __forceinline__ unsigned cvtpk_c(float lo, float hi) { f32x2 v = {lo, hi}; bf16x2_t b = __builtin_convertvector(v, bf16x2_t); return __builtin_bit_cast(unsigned, b); }
__device__ __forceinline__ bf16x8 pack_step(const f32x16& x, int s) { u32x4 p; p.x = cvtpk_c(x[8 * s], x[8 * s + 1]); p.y = cvtpk_c(x[8 * s + 2], x[8 * s + 3]); p.z = cvtpk_c(x[8 * s + 4], x[8 * s + 5]); p.w = cvtpk_c(x[8 * s + 6], x[8 * s + 7]); return __builtin_bit_cast(bf16x8, p); }
__device__ __forceinline__ v4i16_t tr16(const LAS unsigned char* p) { return __builtin_amdgcn_ds_read_tr16_b64_v4i16((LAS v4i16_t*)p); }
__device__ __forceinline__ void att_tile(const LAS unsigned char* kb, const LAS unsigned char* vb, int k0, int lq, int i, int hh, int troff,
                                         const bf16x8 (&qf)[8], f32x16 (&oacc)[4], float& mrun, float& lrun) {
    constexpr float SC = 0.08838834764831845f * 1.4426950408889634f;
    f32x16 sacc, sacc2;
#pragma unroll
    for (int r = 0; r < 16; ++r) { sacc[r] = 0.f; sacc2[r] = 0.f; }
#pragma unroll
    for (int s = 0; s < 8; s += 2) { sacc = __builtin_amdgcn_mfma_f32_32x32x16_bf16(*(const LAS bf16x8*)(kb + i * 272 + 32 * s + 16 * hh), qf[s], sacc, 0, 0, 0);
        sacc2 = __builtin_amdgcn_mfma_f32_32x32x16_bf16(*(const LAS bf16x8*)(kb + i * 272 + 32 * (s + 1) + 16 * hh), qf[s + 1], sacc2, 0, 0, 0); }
#pragma unroll
    for (int r = 0; r < 16; ++r) sacc[r] += sacc2[r];
    float tmax = -1e30f;
    const int dbase = lq - k0 - 4 * hh;
#pragma unroll
    for (int r = 0; r < 16; ++r) { const unsigned dd = (unsigned)(dbase - ((r & 3) + 8 * (r >> 2)));
        const float sv = dd <= 128u ? sacc[r] * SC : -INFINITY; sacc[r] = sv; tmax = fmaxf(tmax, sv); }
    tmax = fmaxf(tmax, __shfl_xor(tmax, 32));
    const float mnew = fmaxf(mrun, tmax);
    const float alpha = __builtin_amdgcn_exp2f(mrun - mnew);
#pragma unroll
    for (int dt = 0; dt < 4; ++dt)
#pragma unroll
        for (int r = 0; r < 16; ++r) oacc[dt][r] *= alpha;
    float psum = 0.f;
#pragma unroll
    for (int r = 0; r < 16; ++r) { const float p = __builtin_amdgcn_exp2f(sacc[r] - mnew); sacc[r] = p; psum += p; }
    psum += __shfl_xor(psum, 32);
    lrun = lrun * alpha + psum; mrun = mnew;
    const bf16x8 pf0 = pack_step(sacc, 0), pf1 = pack_step(sacc, 1);
#pragma unroll
    for (int dt = 0; dt < 4; ++dt) {
        const LAS unsigned char* vp = vb + troff + dt * 64;
        const v4i16_t a0 = tr16(vp), a1 = tr16(vp + 8 * 320), a2 = tr16(vp + 16 * 320), a3 = tr16(vp + 24 * 320);
        const bf16x8 A0 = __builtin_shufflevector(a0, a1, 0, 1, 2, 3, 4, 5, 6, 7), A1 = __builtin_shufflevector(a2, a3, 0, 1, 2, 3, 4, 5, 6, 7);
        oacc[dt] = __builtin_amdgcn_mfma_f32_32x32x16_bf16(A0, pf0, oacc[dt], 0, 0, 0);
        oacc[dt] = __builtin_amdgcn_mfma_f32_32x32x16_bf16(A1, pf1, oacc[dt], 0, 0, 0);
    }
}
__device__ __forceinline__ void attn_wg(const bf16* PROJ, bf16* CONCAT, int wu, LAS unsigned char* L, int tid, int lane, int wave) {
    const int half = wu & 1, bh = (wu >> 1) & 63, blk = 3 - (wu >> 7), h = bh & 15, b = bh >> 4;
    const int rho = 4 * (wave & 3) + 2 * half + (wave >> 2);
    const int i = lane & 31, hh = lane >> 5, l0 = blk * 32;
    const int tq = 16 * (l0 + i) + rho;
    const size_t rowbase = (size_t)b * SEQ;
    bf16x8 qf[8];
    { const bf16* qp = PROJ + (rowbase + tq) * LDP + PJ_Q + h * HD + 8 * hh;
#pragma unroll
      for (int s = 0; s < 8; ++s) qf[s] = *(const bf16x8*)(qp + 16 * s); }
    f32x16 oacc[4];
#pragma unroll
    for (int dt = 0; dt < 4; ++dt)
#pragma unroll
        for (int r = 0; r < 16; ++r) oacc[dt][r] = 0.f;
    float mrun = -1e30f, lrun = 0.f;
    const int g16 = lane >> 4, i16 = lane & 15;
    const int troff = (4 * (g16 >> 1) + (i16 >> 2)) * 320 + (16 * (g16 & 1) + 4 * (i16 & 3)) * 2;
    const bf16* kbase = PROJ + rowbase * LDP + PJ_K + h * HD;
    const bf16* vbase = PROJ + rowbase * LDP + PJ_V + h * HD;
    constexpr int TILE = ATT_VS_BYTES;
    __syncthreads();
    { const int kA = 512 * blk - 128 > 0 ? 512 * blk - 128 : 0, nt = (512 * blk + 511 - kA) / 32 + 1;
      const int row = tid >> 4, ch = tid & 15, lq = tq;
      const bf16* kp = kbase + 8 * ch; const bf16* vp = vbase + 8 * ch;
      LAS unsigned char* kw = L + row * 272 + 16 * ch; LAS unsigned char* vw = L + ATT_KS_BYTES + row * 320 + 16 * ch;
      u32x4 k0r, v0r, k1r, v1r;
#define ATT_LDA(KR, VR, J) do { int tok_ = kA + 32 * (J) + row; tok_ = tok_ < SEQ - 1 ? tok_ : SEQ - 1; KR = *(const u32x4*)(kp + (size_t)tok_ * LDP); VR = *(const u32x4*)(vp + (size_t)tok_ * LDP); } while (0)
#define ATT_STA(KR, VR, P) do { *(LAS u32x4*)(kw + (P) * TILE) = KR; *(LAS u32x4*)(vw + (P) * TILE) = VR; } while (0)
      ATT_LDA(k0r, v0r, 0); ATT_LDA(k1r, v1r, 1);
      ATT_STA(k0r, v0r, 0);
      __syncthreads();
      for (int j = 0; j < nt; j += 2) {
          if (j + 2 < nt) ATT_LDA(k0r, v0r, j + 2);
          att_tile(L, L + ATT_KS_BYTES, kA + 32 * j, lq, i, hh, troff, qf, oacc, mrun, lrun);
          ATT_STA(k1r, v1r, 1);
          __syncthreads();
          if (j + 3 < nt) ATT_LDA(k1r, v1r, j + 3);
          att_tile(L + TILE, L + TILE + ATT_KS_BYTES, kA + 32 * (j + 1), lq, i, hh, troff, qf, oacc, mrun, lrun);
          if (j + 2 < nt) ATT_STA(k0r, v0r, 0);
          __syncthreads();
      }
#undef ATT_LDA
#undef ATT_STA
    }
    { const int kB = 4 * l0 - 128 > 0 ? 4 * l0 - 128 : 0, nt = (4 * l0 + 127 - kB) / 32 + 1;
      const int grp = wave >> 2, tg = tid & 255, row = tg >> 3, ch = 2 * (tg & 7), rd = rho & 3, lq = 4 * (l0 + i) + (rho >> 2);
      LAS unsigned char* gb = L + grp * 2 * TILE;
      u32x4 kr0, kr1, vr0, vr1;
      { int tok = ((kB + row) << 2) + rd; tok = tok < SEQ - 1 ? tok : SEQ - 1; const bf16* kp = kbase + (size_t)tok * LDP + 8 * ch; const bf16* vp = vbase + (size_t)tok * LDP + 8 * ch;
        kr0 = *(const u32x4*)kp; kr1 = *(const u32x4*)(kp + 8); vr0 = *(const u32x4*)vp; vr1 = *(const u32x4*)(vp + 8); }
      { LAS u32x4* kd = (LAS u32x4*)(gb + row * 272 + 16 * ch); kd[0] = kr0; kd[1] = kr1; LAS u32x4* vd = (LAS u32x4*)(gb + ATT_KS_BYTES + row * 320 + 16 * ch); vd[0] = vr0; vd[1] = vr1; }
      __syncthreads();
      for (int j = 0; j < nt; ++j) {
          const bool more = j + 1 < nt;
          if (more) { int tok = ((kB + 32 * (j + 1) + row) << 2) + rd; tok = tok < SEQ - 1 ? tok : SEQ - 1; const bf16* kp = kbase + (size_t)tok * LDP + 8 * ch; const bf16* vp = vbase + (size_t)tok * LDP + 8 * ch;
              kr0 = *(const u32x4*)kp; kr1 = *(const u32x4*)(kp + 8); vr0 = *(const u32x4*)vp; vr1 = *(const u32x4*)(vp + 8); }
          const LAS unsigned char* tb = gb + (j & 1) * TILE;
          att_tile(tb, tb + ATT_KS_BYTES, kB + 32 * j, lq, i, hh, troff, qf, oacc, mrun, lrun);
          if (more) { LAS unsigned char* nb = gb + ((j + 1) & 1) * TILE; LAS u32x4* kd = (LAS u32x4*)(nb + row * 272 + 16 * ch); kd[0] = kr0; kd[1] = kr1;
              LAS u32x4* vd = (LAS u32x4*)(nb + ATT_KS_BYTES + row * 320 + 16 * ch); vd[0] = vr0; vd[1] = vr1; }
          __syncthreads();
      } }
    { const int kC = l0 - 128 > 0 ? l0 - 128 : 0, nt = (l0 + 31 - kC) / 32 + 1, lq = l0 + i;
      LAS unsigned char* wb = L + wave * TILE;
      u32x4 kst[8], vst[8];
#define ATT_LOADC(K0) do { _Pragma("unroll") for (int jj_ = 0; jj_ < 8; ++jj_) { int tok_ = (((K0) + 4 * jj_ + g16) << 4) + rho; tok_ = tok_ < SEQ - 1 ? tok_ : SEQ - 1; \
        kst[jj_] = *(const u32x4*)(kbase + (size_t)tok_ * LDP + 8 * i16); vst[jj_] = *(const u32x4*)(vbase + (size_t)tok_ * LDP + 8 * i16); } } while (0)
      for (int j = 0; j < nt; ++j) {
          ATT_LOADC(kC + 32 * j);
#pragma unroll
          for (int jj = 0; jj < 8; ++jj) { *(LAS u32x4*)(wb + (4 * jj + g16) * 272 + i16 * 16) = kst[jj]; *(LAS u32x4*)(wb + ATT_KS_BYTES + (4 * jj + g16) * 320 + i16 * 16) = vst[jj]; }
          att_tile(wb, wb + ATT_KS_BYTES, kC + 32 * j, lq, i, hh, troff, qf, oacc, mrun, lrun);
      }
#undef ATT_LOADC
    }
    const float inv = 1.0f / lrun;
    bf16* op = CONCAT + (rowbase + tq) * LDD + h * HD + 4 * hh;
#pragma unroll
    for (int dt = 0; dt < 4; ++dt)
#pragma unroll
        for (int g = 0; g < 4; ++g) { u32x2 w; w.x = cvtpk_c(oacc[dt][4 * g] * inv, oacc[dt][4 * g + 1] * inv); w.y = cvtpk_c(oacc[dt][4 * g + 2] * inv, oacc[dt][4 * g + 3] * inv);
            *(u32x2*)(op + 32 * dt + 8 * g) = w; }
}

constexpr int DN_NW = 0, DN_QD = 16896, DN_QK = 33792, DN_KDT = 42496, DN_BLK = 59904;
constexpr int CL_KS = 0, CL_QS = 17408, CL_KT = 34816, CL_VT = 53248, CL_AS = 71680, CL_TW = 89088, CL_TU = 98304, CL_TB = 107520, CL_QK = 116736, CL_TT = 125440, CL_A10 = 128000, CL_GC = 130560, CL_END = 131072;
static_assert(CL_END <= LDSCTL_OFF && 2 * DN_BLK <= LDSCTL_OFF, "DeltaNet LDS maps");
__device__ __forceinline__ int crow16(int reg, int hh) { return (reg & 3) + 8 * (reg >> 2) + 4 * hh; }
__device__ __forceinline__ bf16x8 ld_perm(const LAS unsigned char* p) {
    const v4i16_t lo = *(const LAS v4i16_t*)p, hi = *(const LAS v4i16_t*)(p + 16); return __builtin_shufflevector(lo, hi, 0, 1, 2, 3, 4, 5, 6, 7); }

__device__ __forceinline__ void dn_chunk_local(int unit, const bf16* PROJ, const float* conv_w, const float* GLOG, const float* BETA, unsigned char* blocks, float* Ubuf, float* GL,
                                               LAS unsigned char* L, int tid, int lane, int wave) {
    asm volatile("" : "+v"(tid), "+v"(lane), "+s"(wave));
    const int n = unit & 31, bh = unit >> 5, h = bh & 15, b = bh >> 4, hh = lane >> 5;
    const int m0 = b * SEQ + 64 * n;
    unsigned char* blk = blocks + (size_t)unit * DN_BLK;
    LAS float* cws = (LAS float*)(L + CL_AS);
    LAS float* gcs = (LAS float*)(L + CL_GC); LAS float* betas = gcs + 64;
    for (int e = tid; e < 3 * 4 * 128; e += 512) { const int seg = e >> 9, tap = (e >> 7) & 3, ch = e & 127; cws[e] = conv_w[tap * 6144 + seg * 2048 + h * HD + ch]; }
    float gcv = GLOG[(size_t)(m0 + lane) * 16 + h];
#pragma unroll
    for (int o = 1; o < 64; o <<= 1) { const float t = __shfl_up(gcv, o); if (lane >= o) gcv += t; }
    const float gc_last = __shfl(gcv, 63);
    if (wave == 0) { gcs[lane] = gcv; betas[lane] = BETA[(size_t)(m0 + lane) * 16 + h]; }
    __syncthreads();
    { const int tt = tid >> 3, cg = tid & 7, t = 64 * n + tt;
      const float egc = __expf(__shfl(gcv, tt));
#pragma unroll
      for (int seg = 0; seg < 3; ++seg) {
          float a[16];
#pragma unroll
          for (int e = 0; e < 16; ++e) a[e] = 0.f;
#pragma unroll
          for (int tap = 0; tap < 4; ++tap) { if (t - 3 + tap >= 0) {
              const bf16* pr = PROJ + (size_t)(m0 + tt - 3 + tap) * LDP + PJ_DQKV + seg * 2048 + h * HD + 16 * cg;
              const u32x4 x0 = *(const u32x4*)pr, x1 = *(const u32x4*)(pr + 8);
              const LAS f32x4* w4 = (const LAS f32x4*)(cws + (seg * 4 + tap) * 128 + 16 * cg);
              const f32x4 w0 = w4[0], w1 = w4[1], w2 = w4[2], w3 = w4[3];
              a[0] += w0[0] * bf_lo(x0.x); a[1] += w0[1] * bf_hi(x0.x); a[2] += w0[2] * bf_lo(x0.y); a[3] += w0[3] * bf_hi(x0.y);
              a[4] += w1[0] * bf_lo(x0.z); a[5] += w1[1] * bf_hi(x0.z); a[6] += w1[2] * bf_lo(x0.w); a[7] += w1[3] * bf_hi(x0.w);
              a[8] += w2[0] * bf_lo(x1.x); a[9] += w2[1] * bf_hi(x1.x); a[10] += w2[2] * bf_lo(x1.y); a[11] += w2[3] * bf_hi(x1.y);
              a[12] += w3[0] * bf_lo(x1.z); a[13] += w3[1] * bf_hi(x1.z); a[14] += w3[2] * bf_lo(x1.w); a[15] += w3[3] * bf_hi(x1.w); } }
          float ss = 0.f;
#pragma unroll
          for (int e = 0; e < 16; ++e) { a[e] = pg8::silu_f(a[e]); ss += a[e] * a[e]; }
          if (seg < 2) { ss += __shfl_xor(ss, 1); ss += __shfl_xor(ss, 2); ss += __shfl_xor(ss, 4);
              const float rn = rsqrtf(ss + EPS) * (seg == 0 ? 0.08838834764831845f : 1.0f);
#pragma unroll
              for (int e = 0; e < 16; ++e) a[e] *= rn; }
          if (seg == 0) {
              u32x4 p0, p1; p0.x = cvtpk_c(a[0], a[1]); p0.y = cvtpk_c(a[2], a[3]); p0.z = cvtpk_c(a[4], a[5]); p0.w = cvtpk_c(a[6], a[7]);
              p1.x = cvtpk_c(a[8], a[9]); p1.y = cvtpk_c(a[10], a[11]); p1.z = cvtpk_c(a[12], a[13]); p1.w = cvtpk_c(a[14], a[15]);
              LAS u32x4* qd = (LAS u32x4*)(L + CL_QS + tt * 272 + 32 * cg); qd[0] = p0; qd[1] = p1;
              u32x2* g = (u32x2*)(blk + DN_QD + tt * 264 + 32 * cg);
              u32x2 o; o.x = cvtpk_c(a[0] * egc, a[1] * egc); o.y = cvtpk_c(a[2] * egc, a[3] * egc); g[0] = o;
              o.x = cvtpk_c(a[4] * egc, a[5] * egc); o.y = cvtpk_c(a[6] * egc, a[7] * egc); g[1] = o;
              o.x = cvtpk_c(a[8] * egc, a[9] * egc); o.y = cvtpk_c(a[10] * egc, a[11] * egc); g[2] = o;
              o.x = cvtpk_c(a[12] * egc, a[13] * egc); o.y = cvtpk_c(a[14] * egc, a[15] * egc); g[3] = o;
          } else {
              if (seg == 1) { u32x4 p0, p1; p0.x = cvtpk_c(a[0], a[1]); p0.y = cvtpk_c(a[2], a[3]); p0.z = cvtpk_c(a[4], a[5]); p0.w = cvtpk_c(a[6], a[7]);
                  p1.x = cvtpk_c(a[8], a[9]); p1.y = cvtpk_c(a[10], a[11]); p1.z = cvtpk_c(a[12], a[13]); p1.w = cvtpk_c(a[14], a[15]);
                  LAS u32x4* kd = (LAS u32x4*)(L + CL_KS + tt * 272 + 32 * cg); kd[0] = p0; kd[1] = p1; }
              LAS bf16* tp = (LAS bf16*)(L + (seg == 1 ? CL_KT : CL_VT)) + (16 * cg) * 72 + ((tt + 8 * cg) & 63);
#pragma unroll
              for (int e = 0; e < 16; ++e) tp[e * 72] = (bf16)(cvtpk_c(a[e], 0.f) & 0xffffu);
          }
      } }
    __syncthreads();
    { const int mat = wave >> 2, ti = (wave >> 1) & 1, tj = wave & 1, r = lane & 31;
      f32x16 acc;
#pragma unroll
      for (int i = 0; i < 16; ++i) acc[i] = 0.f;
      if (!(ti == 0 && tj == 1)) {
          const LAS unsigned char* ap = L + (mat == 0 ? CL_KS : CL_QS) + (32 * ti + r) * 272 + 16 * hh;
          const LAS unsigned char* bp = L + CL_KS + (32 * tj + r) * 272 + 16 * hh;
#pragma unroll
          for (int s = 0; s < 8; ++s) acc = __builtin_amdgcn_mfma_f32_32x32x16_bf16(*(const LAS bf16x8*)(ap + 32 * s), *(const LAS bf16x8*)(bp + 32 * s), acc, 0, 0, 0);
      }
      const int j = 32 * tj + r; const float gcj = gcs[j];
#pragma unroll
      for (int reg = 0; reg < 16; ++reg) { const int i = 32 * ti + crow16(reg, hh);
          const float e = (i >= j) ? __expf(gcs[i] - gcj) : 0.f;
          if (mat == 0) { const float val = (i > j) ? betas[i] * acc[reg] * e : 0.f;
              ((LAS float*)(L + CL_AS))[i * 68 + j] = val;
              if (ti == 1 && tj == 0) ((LAS bf16*)(L + CL_A10))[(i - 32) * 40 + j] = (bf16)(cvtpk_c(val, 0.f) & 0xffffu); }
          else ((LAS bf16*)(L + CL_QK))[i * 68 + j] = (bf16)(cvtpk_c(acc[reg] * e, 0.f) & 0xffffu); }
    }
    __syncthreads();
    if (wave == 0) {
        const int half = hh, c = lane & 31, cf = 32 * half + c;
        const LAS float* Ab = (const LAS float*)(L + CL_AS) + (32 * half) * 68 + 32 * half;
        float t[32];
        f32x4 cur[8], nxt[8];
#pragma unroll
        for (int q = 0; q < 8; ++q) { cur[q] = (f32x4){0.f, 0.f, 0.f, 0.f}; nxt[q] = cur[q]; }
#pragma unroll
        for (int i = 0; i < 32; ++i) {
            if (i + 1 < 32) {
#pragma unroll
                for (int j4 = 0; j4 < (i + 4) / 4; ++j4) nxt[j4] = *(const LAS f32x4*)(Ab + (i + 1) * 68 + 4 * j4); }
            float s0 = (i == c) ? 1.f : 0.f, s1 = 0.f;
#pragma unroll
            for (int j4 = 0; j4 < (i + 3) / 4; ++j4) {
#pragma unroll
                for (int e = 0; e < 4; ++e) { const int jj = 4 * j4 + e; if (jj < i) { if (jj & 1) s1 -= cur[j4][e] * t[jj]; else s0 -= cur[j4][e] * t[jj]; } } }
            t[i] = s0 + s1;
#pragma unroll
            for (int q = 0; q < 8; ++q) cur[q] = nxt[q];
            asm volatile("" : "+v"(t[i]) :: "memory");
        }
        const float csu = betas[cf], csw = csu * __expf(gcs[cf]);
        LAS bf16* Tw = (LAS bf16*)(L + CL_TW); LAS bf16* Tu = (LAS bf16*)(L + CL_TU); LAS bf16* Tb = (LAS bf16*)(L + CL_TB);
#pragma unroll
        for (int i = 0; i < 32; ++i) { const int rf = 32 * half + i;
            Tw[rf * 72 + cf] = (bf16)(cvtpk_c(t[i] * csw, 0.f) & 0xffffu); Tu[rf * 72 + cf] = (bf16)(cvtpk_c(t[i] * csu, 0.f) & 0xffffu);
            if (half == 1) { Tb[rf * 72 + cf] = (bf16)(cvtpk_c(t[i], 0.f) & 0xffffu); Tw[i * 72 + cf] = 0; Tu[i * 72 + cf] = 0; } }
        if (half == 0) { LAS u32x4* tt4 = (LAS u32x4*)(L + CL_TT + c * 80);
#pragma unroll
            for (int q = 0; q < 4; ++q) { u32x4 w; w.x = cvtpk_c(t[8 * q], t[8 * q + 1]); w.y = cvtpk_c(t[8 * q + 2], t[8 * q + 3]); w.z = cvtpk_c(t[8 * q + 4], t[8 * q + 5]); w.w = cvtpk_c(t[8 * q + 6], t[8 * q + 7]); tt4[q] = w; } }
        f32x16 xacc, tacc;
#pragma unroll
        for (int i = 0; i < 16; ++i) { xacc[i] = 0.f; tacc[i] = 0.f; }
#pragma unroll
        for (int s = 0; s < 2; ++s) xacc = __builtin_amdgcn_mfma_f32_32x32x16_bf16(*(const LAS bf16x8*)(L + CL_A10 + c * 80 + 32 * s + 16 * hh), *(const LAS bf16x8*)(L + CL_TT + c * 80 + 32 * s + 16 * hh), xacc, 0, 0, 0);
#pragma unroll
        for (int s = 0; s < 2; ++s) tacc = __builtin_amdgcn_mfma_f32_32x32x16_bf16(ld_perm(L + CL_TB + (32 + c) * 144 + (32 + 16 * s + 4 * hh) * 2), pack_step(xacc, s), tacc, 0, 0, 0);
        const float c0u = betas[c], c0w = c0u * __expf(gcs[c]);
#pragma unroll
        for (int reg = 0; reg < 16; ++reg) { const int i = 32 + crow16(reg, hh); const float v = -tacc[reg];
            Tw[i * 72 + c] = (bf16)(cvtpk_c(v * c0w, 0.f) & 0xffffu); Tu[i * 72 + c] = (bf16)(cvtpk_c(v * c0u, 0.f) & 0xffffu); }
    } else {
        const int t7 = tid - 64;
        for (int e = t7; e < 8704 / 8; e += 448) *(u32x2*)(blk + DN_QK + 8 * e) = *(const LAS u32x2*)(L + CL_QK + 8 * e);
        for (int e = t7; e < 128 * 8; e += 448) { const int dk = e >> 3, c8 = e & 7;
            const u32x4 kk = *(const LAS u32x4*)(L + CL_KT + dk * 144 + 16 * ((c8 + (dk >> 4)) & 7));
            const LAS float* gp = gcs + 8 * c8; float kd[8];
#pragma unroll
            for (int q = 0; q < 8; ++q) kd[q] = __expf(gc_last - gp[q]);
            u32x2 o0, o1; o0.x = cvtpk_c(bf_lo(kk.x) * kd[0], bf_hi(kk.x) * kd[1]); o0.y = cvtpk_c(bf_lo(kk.y) * kd[2], bf_hi(kk.y) * kd[3]);
            o1.x = cvtpk_c(bf_lo(kk.z) * kd[4], bf_hi(kk.z) * kd[5]); o1.y = cvtpk_c(bf_lo(kk.w) * kd[6], bf_hi(kk.w) * kd[7]);
            u32x2* g = (u32x2*)(blk + DN_KDT + dk * 136 + 16 * c8); g[0] = o0; g[1] = o1; }
        if (t7 == 0) GL[unit] = __expf(gc_last);
    }
    __syncthreads();
    { const int r = lane & 31;
      { const int dkt = wave >> 1, it = wave & 1, dk = 32 * dkt + r;
        f32x16 acc;
#pragma unroll
        for (int i = 0; i < 16; ++i) acc[i] = 0.f;
#pragma unroll
        for (int s = 0; s < 4; ++s) acc = __builtin_amdgcn_mfma_f32_32x32x16_bf16(*(const LAS bf16x8*)(L + CL_KT + dk * 144 + 16 * ((2 * s + hh + (dk >> 4)) & 7)),
                                                                                  *(const LAS bf16x8*)(L + CL_TW + (32 * it + r) * 144 + 32 * s + 16 * hh), acc, 0, 0, 0);
        LAS unsigned char* wp = L + CL_KS + (32 * it + r) * 264 + (32 * dkt + 4 * hh) * 2;
#pragma unroll
        for (int g = 0; g < 4; ++g) { u32x2 w; w.x = cvtpk_c(-acc[4 * g], -acc[4 * g + 1]); w.y = cvtpk_c(-acc[4 * g + 2], -acc[4 * g + 3]); *(LAS u32x2*)(wp + 16 * g) = w; } }
      { const int it = wave >> 2, dvt = wave & 3, dv = 32 * dvt + r;
        f32x16 acc;
#pragma unroll
        for (int i = 0; i < 16; ++i) acc[i] = 0.f;
#pragma unroll
        for (int s = 0; s < 4; ++s) acc = __builtin_amdgcn_mfma_f32_32x32x16_bf16(*(const LAS bf16x8*)(L + CL_TU + (32 * it + r) * 144 + 32 * s + 16 * hh),
                                                                                  *(const LAS bf16x8*)(L + CL_VT + dv * 144 + 16 * ((2 * s + hh + (dv >> 4)) & 7)), acc, 0, 0, 0);
        float* up = Ubuf + (size_t)unit * 8192 + (dvt * 2 + it) * 1024 + lane;
#pragma unroll
        for (int reg = 0; reg < 16; ++reg) up[64 * reg] = acc[reg]; } }
    __syncthreads();
    for (int e = tid; e < 16896 / 16; e += 512) *(u32x4*)(blk + DN_NW + 16 * e) = *(const LAS u32x4*)(L + CL_KS + 16 * e);
    __syncthreads();
}

__device__ __forceinline__ void dn_gate_rows(int bh, const float* ORAW, const bf16* PROJ, const float* dn_norm, bf16* CONCAT, int lane, int wave) {
    const int h = bh & 15, b = bh >> 4, sub = lane >> 4, c = 8 * (lane & 15);
    const f32x4 g0 = *(const f32x4*)(dn_norm + c), g1 = *(const f32x4*)(dn_norm + c + 4);
    for (int t0 = wave * 256; t0 < wave * 256 + 256; t0 += 16) {
        f32x4 o0[4], o1[4]; u32x4 zz[4];
#pragma unroll
        for (int u = 0; u < 4; ++u) { const size_t m = (size_t)b * SEQ + t0 + 4 * u + sub; const float* op = ORAW + m * 2048 + h * HD + c;
            o0[u] = *(const f32x4*)op; o1[u] = *(const f32x4*)(op + 4); zz[u] = *(const u32x4*)(PROJ + m * LDP + PJ_DZ + h * HD + c); }
#pragma unroll
        for (int u = 0; u < 4; ++u) { const size_t m = (size_t)b * SEQ + t0 + 4 * u + sub;
            float ss = (o0[u][0] * o0[u][0] + o0[u][1] * o0[u][1]) + (o0[u][2] * o0[u][2] + o0[u][3] * o0[u][3]) + (o1[u][0] * o1[u][0] + o1[u][1] * o1[u][1]) + (o1[u][2] * o1[u][2] + o1[u][3] * o1[u][3]);
            ss += __shfl_xor(ss, 1); ss += __shfl_xor(ss, 2); ss += __shfl_xor(ss, 4); ss += __shfl_xor(ss, 8);
            const float r = rsqrtf(ss * (1.0f / HD) + EPS);
            u32x4 w;
            w.x = pk2(o0[u][0] * r * g0[0] * pg8::silu_f(bf_lo(zz[u].x)), o0[u][1] * r * g0[1] * pg8::silu_f(bf_hi(zz[u].x)));
            w.y = pk2(o0[u][2] * r * g0[2] * pg8::silu_f(bf_lo(zz[u].y)), o0[u][3] * r * g0[3] * pg8::silu_f(bf_hi(zz[u].y)));
            w.z = pk2(o1[u][0] * r * g1[0] * pg8::silu_f(bf_lo(zz[u].z)), o1[u][1] * r * g1[1] * pg8::silu_f(bf_hi(zz[u].z)));
            w.w = pk2(o1[u][2] * r * g1[2] * pg8::silu_f(bf_lo(zz[u].w)), o1[u][3] * r * g1[3] * pg8::silu_f(bf_hi(zz[u].w)));
            *(u32x4*)(CONCAT + m * LDD + 2048 + h * HD + c) = w; }
    }
}
__device__ __forceinline__ void dn_scan(int bh, const unsigned char* blocks, const float* Ubuf, const float* GL, float* ORAW, LAS unsigned char* L, int tid, int lane, int wave) {
    const int h = bh & 15, b = bh >> 4;
    if (wave >= 4) {
        const unsigned char* src = blocks + (size_t)(bh * 32) * DN_BLK;
        { u32x4 v[15];
#pragma unroll
          for (int j = 0; j < 15; ++j) { const int e = tid - 256 + 256 * j; if (e < DN_BLK / 16) v[j] = *(const u32x4*)(src + 16 * e); }
#pragma unroll
          for (int j = 0; j < 15; ++j) { const int e = tid - 256 + 256 * j; if (e < DN_BLK / 16) *(LAS u32x4*)(L + 16 * e) = v[j]; } }
        for (int n = 0; n < 32; ++n) {
            __syncthreads();
            if (n + 1 < 32) { const unsigned char* sp = src + (size_t)(n + 1) * DN_BLK; LAS unsigned char* dst = L + ((n + 1) & 1) * DN_BLK;
                u32x4 v[15];
#pragma unroll
                for (int j = 0; j < 15; ++j) { const int e = tid - 256 + 256 * j; if (e < DN_BLK / 16) v[j] = *(const u32x4*)(sp + 16 * e); }
#pragma unroll
                for (int j = 0; j < 15; ++j) { const int e = tid - 256 + 256 * j; if (e < DN_BLK / 16) *(LAS u32x4*)(dst + 16 * e) = v[j]; } }
        }
        __syncthreads();
        return;
    }
    int r = lane & 31, hh = lane >> 5;
    f32x16 Sacc[4];
#pragma unroll
    for (int t = 0; t < 4; ++t)
#pragma unroll
        for (int i = 0; i < 16; ++i) Sacc[t][i] = 0.f;
    const float* up = Ubuf + (size_t)(bh * 32) * 8192 + (wave * 2) * 1024 + lane;
    float* op = ORAW + (size_t)(b * SEQ) * 2048 + h * HD + 32 * wave + r;
    for (int n = 0; n < 32; ++n) {
        f32x16 x0, x1;
#pragma unroll
        for (int reg = 0; reg < 16; ++reg) { x0[reg] = up[64 * reg]; x1[reg] = up[1024 + 64 * reg]; }
        const float gl = GL[bh * 32 + n];
        __syncthreads();
        const LAS unsigned char* B = L + (n & 1) * DN_BLK;
#pragma unroll
        for (int t = 0; t < 4; ++t)
#pragma unroll
            for (int s = 0; s < 2; ++s) { const bf16x8 sb = pack_step(Sacc[t], s); const int co = (32 * t + 16 * s + 4 * hh) * 2;
                x0 = __builtin_amdgcn_mfma_f32_32x32x16_bf16(ld_perm(B + DN_NW + r * 264 + co), sb, x0, 0, 0, 0);
                x1 = __builtin_amdgcn_mfma_f32_32x32x16_bf16(ld_perm(B + DN_NW + (32 + r) * 264 + co), sb, x1, 0, 0, 0); }
        const bf16x8 v00 = pack_step(x0, 0), v01 = pack_step(x0, 1), v10 = pack_step(x1, 0), v11 = pack_step(x1, 1);
        f32x16 o0, o1;
#pragma unroll
        for (int i = 0; i < 16; ++i) { o0[i] = 0.f; o1[i] = 0.f; }
#pragma unroll
        for (int t = 0; t < 4; ++t)
#pragma unroll
            for (int s = 0; s < 2; ++s) { const bf16x8 sb = pack_step(Sacc[t], s); const int co = (32 * t + 16 * s + 4 * hh) * 2;
                o0 = __builtin_amdgcn_mfma_f32_32x32x16_bf16(ld_perm(B + DN_QD + r * 264 + co), sb, o0, 0, 0, 0);
                o1 = __builtin_amdgcn_mfma_f32_32x32x16_bf16(ld_perm(B + DN_QD + (32 + r) * 264 + co), sb, o1, 0, 0, 0); }
        o0 = __builtin_amdgcn_mfma_f32_32x32x16_bf16(ld_perm(B + DN_QK + r * 136 + (4 * hh) * 2), v00, o0, 0, 0, 0);
        o0 = __builtin_amdgcn_mfma_f32_32x32x16_bf16(ld_perm(B + DN_QK + r * 136 + (16 + 4 * hh) * 2), v01, o0, 0, 0, 0);
        o1 = __builtin_amdgcn_mfma_f32_32x32x16_bf16(ld_perm(B + DN_QK + (32 + r) * 136 + (4 * hh) * 2), v00, o1, 0, 0, 0);
        o1 = __builtin_amdgcn_mfma_f32_32x32x16_bf16(ld_perm(B + DN_QK + (32 + r) * 136 + (16 + 4 * hh) * 2), v01, o1, 0, 0, 0);
        o1 = __builtin_amdgcn_mfma_f32_32x32x16_bf16(ld_perm(B + DN_QK + (32 + r) * 136 + (32 + 4 * hh) * 2), v10, o1, 0, 0, 0);
        o1 = __builtin_amdgcn_mfma_f32_32x32x16_bf16(ld_perm(B + DN_QK + (32 + r) * 136 + (48 + 4 * hh) * 2), v11, o1, 0, 0, 0);
#pragma unroll
        for (int reg = 0; reg < 16; ++reg) { const int i = crow16(reg, hh); op[(size_t)i * 2048] = o0[reg]; op[(size_t)(32 + i) * 2048] = o1[reg]; }
#pragma unroll
        for (int t = 0; t < 4; ++t) {
#pragma unroll
            for (int i = 0; i < 16; ++i) Sacc[t][i] *= gl;
            const LAS unsigned char* kp = B + DN_KDT + (32 * t + r) * 136 + (4 * hh) * 2;
            Sacc[t] = __builtin_amdgcn_mfma_f32_32x32x16_bf16(ld_perm(kp), v00, Sacc[t], 0, 0, 0);
            Sacc[t] = __builtin_amdgcn_mfma_f32_32x32x16_bf16(ld_perm(kp + 32), v01, Sacc[t], 0, 0, 0);
            Sacc[t] = __builtin_amdgcn_mfma_f32_32x32x16_bf16(ld_perm(kp + 64), v10, Sacc[t], 0, 0, 0);
            Sacc[t] = __builtin_amdgcn_mfma_f32_32x32x16_bf16(ld_perm(kp + 96), v11, Sacc[t], 0, 0, 0); }
        up += 8192; op += (size_t)64 * 2048;
    }
    __syncthreads();
}

struct Args { const float* in[17]; float* out; unsigned char* ws; int ph_lo, ph_hi; };
constexpr int NPH = 11;

__global__ void __launch_bounds__(NWAVES * 64, 2) fwd(Args args) {
    extern __shared__ __attribute__((aligned(16))) unsigned char lds[];
    LAS unsigned char* L = (LAS unsigned char*)lds;
    volatile LAS unsigned* MISC = (volatile LAS unsigned*)(L + MISC_OFF);
    const int wave = __builtin_amdgcn_readfirstlane((int)threadIdx.x >> 6);
    int lane = fresh_lane(), tid = wave * 64 + lane;
#define REFRESH_IDS() do { lane = fresh_lane(); tid = wave * 64 + lane; } while (0)
    const int G = gridDim.x; const int bx = blockIdx.x; const int vcu = (G % 8 == 0) ? (bx % 8) * (G / 8) + bx / 8 : bx;
    const int gw = vcu * NWAVES + wave, NGW = G * NWAVES;
    unsigned char* ws = args.ws;
    unsigned* ctl = (unsigned*)(ws + WS_CTL);
    const float* x = args.in[0];
    float* out = args.out;
    unsigned long long* ssq = (unsigned long long*)(ws + WS_SSQ);
    float* BETA = (float*)(ws + WS_BETA); float* GLOG = (float*)(ws + WS_G);
    bf16* Wgu1 = (bf16*)(ws + WS_WGU1); bf16* Wd1 = (bf16*)(ws + WS_WD1); bf16* Win = (bf16*)(ws + WS_WIN); bf16* Wout = (bf16*)(ws + WS_WOUT);
    bf16* Wgu2 = (bf16*)(ws + WS_WGU2); bf16* Wd2 = (bf16*)(ws + WS_WD2);
    bf16* XB = (bf16*)(ws + WS_XB); bf16* ACT = (bf16*)(ws + WS_ACT); bf16* PROJ = (bf16*)(ws + WS_PROJ); bf16* CONCAT = (bf16*)(ws + WS_CONCAT);
    unsigned char* DNB = ws + WS_ACT; float* UBUF = (float*)(ws + WS_QN); float* GLAST = (float*)(ws + WS_GL); float* ORAW = (float*)(ws + WS_ORAW);

    for (int u = tid; u < (LDS_BYTES - LDSCTL_OFF) / 4; u += NWAVES * 64) ((LAS unsigned*)(L + LDSCTL_OFF))[u] = 0u;
    __syncthreads();
    XcdBarrier bar; bar.bar = ctl + CW_BAR; bar.x = 0; bar.st = nullptr; bar.w = wave;
#if ONE_LAUNCH
    bar = xcd_barrier_post(ctl + CW_BAR, MISC + 8); bar.w = wave;
#define GRID_BAR() xcd_barrier(bar)
#else
#define GRID_BAR() do { } while (0)
#endif
    const int lo = args.ph_lo, hi = args.ph_hi;
#define IN(k) (lo <= (k) && (k) < hi)
#define BOTH(k) (IN(k) && IN((k) + 1))

    constexpr int T_GU = (D / 64) * (FF / 64), T_DN = (FF / 64) * (D / 64), NT_IN = (NPROJ + 63) / 64, T_IN = (D / 64) * NT_IN, T_OUT = (D / 64) * (D / 64);
    constexpr int NITEMS = 4 * T_GU + 2 * T_DN + T_IN + T_OUT, NI0 = 2 * T_GU + T_DN + T_IN, NCB = (NITEMS - NI0) / 64;
    static_assert((NITEMS - NI0) % 64 == 0, "deferred conversion tiles come in whole batches");
#define P0T_SET(x, pw_, pg_, pt_, pk_, pn_, pkk_, pnn_, pld_, pb_, po_) do { x##W = (pw_); x##G = (pg_); x##T = (pt_); x##K = (pk_); x##N = (pn_); x##k0 = (pkk_); x##n0 = (pnn_); x##ld = (pld_); x##blk = (pb_); x##off = (po_); } while (0)
#define P0T_RESOLVE(x, item) do { int r_ = (item); \
            if (r_ < 2 * T_GU) { const int wh_ = r_ / T_GU; r_ -= wh_ * T_GU; P0T_SET(x, args.in[2 + wh_], args.in[1], Wgu1, D, FF, 64 * (r_ / (FF / 64)), 64 * (r_ % (FF / 64)), LDD, 256, 128 * wh_); break; } r_ -= 2 * T_GU; \
            if (r_ < T_DN) { P0T_SET(x, args.in[4], nullptr, Wd1, FF, D, 64 * (r_ / (D / 64)), 64 * (r_ % (D / 64)), LDF, 128, 0); break; } r_ -= T_DN; \
            if (r_ < T_IN) { P0T_SET(x, args.in[6], args.in[5], Win, D, NPROJ, 64 * (r_ / NT_IN), 64 * (r_ % NT_IN), LDD, 128, 0); break; } r_ -= T_IN; \
            if (r_ < T_OUT) { P0T_SET(x, args.in[11], nullptr, Wout, D, D, 64 * (r_ / (D / 64)), 64 * (r_ % (D / 64)), LDD, 128, 0); break; } r_ -= T_OUT; \
            if (r_ < 2 * T_GU) { const int wh_ = r_ / T_GU; r_ -= wh_ * T_GU; P0T_SET(x, args.in[13 + wh_], args.in[12], Wgu2, D, FF, 64 * (r_ / (FF / 64)), 64 * (r_ % (FF / 64)), LDD, 256, 128 * wh_); break; } r_ -= 2 * T_GU; \
            P0T_SET(x, args.in[15], nullptr, Wd2, FF, D, 64 * (r_ / (D / 64)), 64 * (r_ % (D / 64)), LDF, 128, 0); } while (0)
#define P0_RUN(first, end, stride) do { if ((first) < (end)) { \
            f32x4 va[16], vb[16]; P0T_DECL(a); P0T_DECL(b); \
            P0T_RESOLVE(a, (first)); p0_load(aW, aN, ak0, an0, lane, va); \
            for (int it = (first); it < (end); it += 2 * (stride)) {             \
                const bool hb = it + (stride) < (end); if (hb) { P0T_RESOLVE(b, it + (stride)); p0_load(bW, bN, bk0, bn0, lane, vb); } \
                p0_finish(aT, aG, aN, ak0, an0, ald, ablk, aoff, lane, va, scr); \
                if (!hb) break; \
                const bool ha = it + 2 * (stride) < (end); if (ha) { P0T_RESOLVE(a, it + 2 * (stride)); p0_load(aW, aN, ak0, an0, lane, va); } \
                p0_finish(bT, bG, bN, bk0, bn0, bld, bblk, boff, lane, vb, scr); \
            } } } while (0)
    constexpr int NTD = NITEMS - NI0;
#define TAIL_FILL(k) do { REFRESH_IDS(); __syncthreads(); \
        if (tid == 0) __hip_atomic_fetch_add(ctl + CW_DONE + 64 * (k), 1u, __ATOMIC_RELAXED, __HIP_MEMORY_SCOPE_AGENT); \
        LAS float* scr = (LAS float*)(L + wave * (64 * 65 * 4)); \
        for (;;) { unsigned d_ = 0u, t_ = 0u; \
            if (lane == 0) { d_ = __hip_atomic_load(ctl + CW_DONE + 64 * (k), __ATOMIC_RELAXED, __HIP_MEMORY_SCOPE_AGENT); if (d_ < (unsigned)G) t_ = __hip_atomic_fetch_add(ctl + CW_TQ, 1u, __ATOMIC_RELAXED, __HIP_MEMORY_SCOPE_AGENT); } \
            d_ = (unsigned)__builtin_amdgcn_readfirstlane((int)d_); t_ = (unsigned)__builtin_amdgcn_readfirstlane((int)t_); \
            if (d_ >= (unsigned)G || t_ >= (unsigned)NTD) break; \
            f32x4 va[16]; P0T_DECL(a); P0T_RESOLVE(a, NI0 + (int)t_); p0_load(aW, aN, ak0, an0, lane, va); p0_finish(aT, aG, aN, ak0, an0, ald, ablk, aoff, lane, va, scr); } } while (0)
    if (IN(0)) {
        REFRESH_IDS();
        LAS float* scr = (LAS float*)(L + wave * (64 * 65 * 4));
        P0_RUN(gw, NI0, NGW);
        for (int row = gw; row < M; row += NGW) {
            const f32x4* xr = (const f32x4*)(x + (size_t)row * D) + lane; float s = 0.f;
#pragma unroll
            for (int j = 0; j < 16; ++j) { const f32x4 v = xr[64 * j]; s += (v[0] * v[0] + v[1] * v[1]) + (v[2] * v[2] + v[3] * v[3]);
                u32x2 o; o.x = pk2(v[0], v[1]); o.y = pk2(v[2], v[3]); *(u32x2*)(XB + (size_t)row * LDD + 4 * lane + 256 * j) = o; }
            s = wave_sum(s);
            if (lane == 0) ssq[row] = (unsigned long long)(s * FIXS);
        }
        if (BOTH(0)) GRID_BAR();
    }

    if (IN(1)) {
        REFRESH_IDS();
        pg8::Gemm g{XB, Wgu1, M, 2 * FF, D, LDD, LDD}; pg8::StaticOrder S; S.init(M, 2 * FF, G, bx);
        pg8::EpiGateUp E{ACT, ssq};
        pg8::gemm_phase<pg8::EpiGateUp, pg8::StaticOrder, true, true>(L, g, S, E, wave);
        TAIL_FILL(1);
        if (BOTH(1)) GRID_BAR();
    }
    if (IN(2)) {
        REFRESH_IDS();
        pg8::Gemm g{ACT, Wd1, M, D, FF, LDF, LDF}; pg8::StaticOrder S; S.init(M, D, G, bx);
        pg8::EpiResid<true> E{x, out, XB, ssq + M, 0.5f};
        pg8::gemm_phase<pg8::EpiResid<true>, pg8::StaticOrder, true, true>(L, g, S, E, wave);
        TAIL_FILL(2);
        if (BOTH(2)) GRID_BAR();
    }
    if (IN(3)) {
        REFRESH_IDS();
        {
            for (int rt = bx; rt < M / 32; rt += G) {
                const int r = lane & 31, hh = lane >> 5;
                const bf16* ap = XB + (size_t)(32 * rt + r) * LDD + wave * 512 + 8 * hh;
                const bf16* bp = Win + (size_t)(NPROJ_MAIN + r) * LDD + wave * 512 + 8 * hh;
                f32x16 acc; for (int i = 0; i < 16; ++i) acc[i] = 0.f;
#pragma unroll 8
                for (int kk = 0; kk < 32; ++kk) { const bf16x8 a = *(const bf16x8*)(ap + 16 * kk), b = *(const bf16x8*)(bp + 16 * kk);
                    acc = __builtin_amdgcn_mfma_f32_32x32x16_bf16(a, b, acc, 0, 0, 0); }
                LAS float* red = (LAS float*)L;
                __syncthreads();
#pragma unroll
                for (int i = 0; i < 16; ++i) red[(wave * 64 + lane) * 16 + i] = acc[i];
                __syncthreads();
#pragma unroll
                for (int q = 0; q < 2; ++q) { const int idx = tid + 512 * q, ln = idx >> 4, reg = idx & 15; float s = 0.f;
#pragma unroll
                    for (int w = 0; w < 8; ++w) s += red[(w * 64 + ln) * 16 + reg];
                    const int col = ln & 31, rowi = (reg & 3) + 8 * (reg >> 2) + 4 * (ln >> 5), row = 32 * rt + rowi;
                    const float val = s * pg8::rstd_of(ssq + M, row);
                    if (col < 16) BETA[row * 16 + col] = 1.0f / (1.0f + __expf(-val));
                    else { const int h = col - 16; const float z = val + args.in[9][h]; const float sp = fmaxf(z, 0.f) + log1pf(__expf(-fabsf(z)));
                        GLOG[row * 16 + h] = -__expf(args.in[8][h]) * sp; } }
            }
            __syncthreads();
        }
        pg8::Gemm g{XB, Win, M, NPROJ_MAIN, D, LDD, LDD}; pg8::StaticOrder S; S.init(M, NPROJ_MAIN, G, bx);
        pg8::EpiProj E{PROJ, ssq + M};
        pg8::gemm_phase<pg8::EpiProj, pg8::StaticOrder, true, true>(L, g, S, E, wave);
        TAIL_FILL(3);
        if (BOTH(3)) GRID_BAR();
    }
    if (IN(4)) {
        REFRESH_IDS();
        for (int unit = vcu; unit < 2048; unit += G) dn_chunk_local(unit, PROJ, args.in[7], GLOG, BETA, DNB, UBUF, GLAST, L, tid, lane, wave);
        TAIL_FILL(4);
        if (BOTH(4)) GRID_BAR();
    }
    if (IN(5)) {
        REFRESH_IDS();
        if (vcu < 64) { dn_scan(vcu, DNB, UBUF, GLAST, ORAW, L, tid, lane, wave);
            REFRESH_IDS(); dn_gate_rows(vcu, ORAW, PROJ, args.in[10], CONCAT, lane, wave); REFRESH_IDS(); }
        { LAS float* scr = (LAS float*)(L + wave * (64 * 65 * 4));
          for (;;) {
            __syncthreads();
            if (tid == 0) { MISC[16] = __hip_atomic_fetch_add(ctl + CW_AQ, 1u, __ATOMIC_RELAXED, __HIP_MEMORY_SCOPE_AGENT); MISC[17] = __hip_atomic_fetch_add(ctl + CW_TQ, 64u, __ATOMIC_RELAXED, __HIP_MEMORY_SCOPE_AGENT); }
            __syncthreads();
            const unsigned qa = (unsigned)__builtin_amdgcn_readfirstlane((int)MISC[16]); unsigned qc = (unsigned)__builtin_amdgcn_readfirstlane((int)MISC[17]); if (qa >= 512u && qc >= (unsigned)NTD) break;
            REFRESH_IDS();
            if (qa < 512u) attn_wg(PROJ, CONCAT, (int)qa, L, tid, lane, wave);
            if (qc < (unsigned)NTD) {
                __syncthreads(); REFRESH_IDS(); asm volatile("" : "+s"(qc));
#define CV_T(k) (NI0 + ((int)qc + wave + 8 * (k) < NTD ? (int)qc + wave + 8 * (k) : NTD - 1))
                f32x4 va[16], vb[16]; P0T_DECL(a); P0T_DECL(b);
#define CV_LA(k) do { P0T_RESOLVE(a, CV_T(k)); p0_load(aW, aN, ak0, an0, lane, va); } while (0)
#define CV_LB(k) do { P0T_RESOLVE(b, CV_T(k)); p0_load(bW, bN, bk0, bn0, lane, vb); } while (0)
#define CV_FA() p0_finish(aT, aG, aN, ak0, an0, ald, ablk, aoff, lane, va, scr)
#define CV_FB() p0_finish(bT, bG, bN, bk0, bn0, bld, bblk, boff, lane, vb, scr)
                CV_LA(0); CV_LB(1); CV_FA(); CV_LA(2); CV_FB(); CV_LB(3); CV_FA(); CV_LA(4); CV_FB(); CV_LB(5); CV_FA(); CV_LA(6); CV_FB(); CV_LB(7); CV_FA(); CV_FB();
#undef CV_LA
#undef CV_LB
#undef CV_FA
#undef CV_FB
#undef CV_T
            }
          } }
        if (BOTH(5)) GRID_BAR();
    }
    if (IN(7)) {
        REFRESH_IDS();
        pg8::Gemm g{CONCAT, Wout, M, D, D, LDD, LDD}; pg8::StaticOrder S; S.init(M, D, G, bx);
        pg8::EpiResid<true> E{out, out, XB, ssq + 2 * M, 1.0f};
        pg8::gemm_phase<pg8::EpiResid<true>, pg8::StaticOrder, true, true>(L, g, S, E, wave);
        if (BOTH(7)) GRID_BAR();
    }
    if (IN(8)) {
        REFRESH_IDS();
        pg8::Gemm g{XB, Wgu2, M, 2 * FF, D, LDD, LDD}; pg8::StaticOrder S; S.init(M, 2 * FF, G, bx);
        pg8::EpiGateUp E{ACT, ssq + 2 * M};
        pg8::gemm_phase<pg8::EpiGateUp, pg8::StaticOrder, true, true>(L, g, S, E, wave);
        if (BOTH(8)) GRID_BAR();
    }
    if (IN(9)) {
        REFRESH_IDS();
        pg8::Gemm g{ACT, Wd2, M, D, FF, LDF, LDF}; pg8::StaticOrder S; S.init(M, D, G, bx);
        pg8::EpiResid<true, false> E{out, out, XB, ssq + 3 * M, 0.5f};
        pg8::gemm_phase<pg8::EpiResid<true, false>, pg8::StaticOrder, true, true>(L, g, S, E, wave);
        if (BOTH(9)) GRID_BAR();
    }
    if (IN(10)) {
        REFRESH_IDS();
        const float* fn = args.in[16];
        for (int row = gw; row < M; row += NGW) {
            const float rs = pg8::rstd_of(ssq + 3 * M, row);
            const u32x4* hr = (const u32x4*)(XB + (size_t)row * LDD) + lane; f32x4* orow = (f32x4*)(out + (size_t)row * D) + 2 * lane; const f32x4* gp = (const f32x4*)fn + 2 * lane;
#pragma unroll
            for (int j = 0; j < 8; ++j) { const u32x4 hv = hr[64 * j]; const f32x4 g0 = gp[128 * j], g1 = gp[128 * j + 1];
                f32x4 o0, o1; o0[0] = bf_lo(hv.x) * rs * g0[0]; o0[1] = bf_hi(hv.x) * rs * g0[1]; o0[2] = bf_lo(hv.y) * rs * g0[2]; o0[3] = bf_hi(hv.y) * rs * g0[3];
                o1[0] = bf_lo(hv.z) * rs * g1[0]; o1[1] = bf_hi(hv.z) * rs * g1[1]; o1[2] = bf_lo(hv.w) * rs * g1[2]; o1[3] = bf_hi(hv.w) * rs * g1[3];
                orow[128 * j] = o0; orow[128 * j + 1] = o1; }
        }
    }
#if PROBE_X
    if (IN(11)) {
        pg8::Gemm g{XB, Wgu1, M, 2 * FF, D, LDD, LDD}; pg8::StaticOrder S; S.init(M, 2 * FF, G, bx);
        pg8::EpiNull E{(float*)(ws + WS_ORAW)};
        pg8::gemm_phase<pg8::EpiNull, pg8::StaticOrder, true, true>(L, g, S, E, wave);
    }
    if (IN(12)) {
        pg8::Gemm g{XB, Wgu1, M, 2 * FF, D, LDD, LDD}; pg8::MaskOrder S; S.init(M, 2 * FF, G, bx); S.mm = 1; S.mn = 1;
        pg8::EpiNull E{(float*)(ws + WS_ORAW)};
        pg8::gemm_phase<pg8::EpiNull, pg8::MaskOrder, true, true>(L, g, S, E, wave);
    }
    if (IN(13)) {
        pg8::Gemm g{XB, Wgu1, M, 2 * FF, D, LDD, LDD}; pg8::StaticOrder S; S.init(M, 2 * FF, G, bx);
        pg8::EpiGateUp E{ACT, ssq};
        pg8::gemm_phase<pg8::EpiGateUp, pg8::StaticOrder, true, true>(L, g, S, E, wave);
    }
    if (IN(14)) {
        pg8::Gemm g{ACT, Wd1, M, D, FF, LDF, LDF}; pg8::StaticOrder S; S.init(M, D, G, bx);
        pg8::EpiNull E{(float*)(ws + WS_ORAW)};
        pg8::gemm_phase<pg8::EpiNull, pg8::StaticOrder, true, true>(L, g, S, E, wave);
    }
#endif
#undef TAIL_FILL
#undef P0_RUN
#undef P0T_RESOLVE
#undef P0T_SET
#undef IN
#undef BOTH
}

extern "C" void kernel_launch(void* const* d_in, const int* in_sizes, int n_in, void* d_out, int out_size, void* d_ws, size_t ws_size, hipStream_t stream) {
    static int grid = 0;
    if (grid == 0) {
        if (n_in != 17 || in_sizes[0] != M * D || out_size != M * D || ws_size < WS_END) { fprintf(stderr, "kernel_launch: unexpected shapes (n_in %d, in0 %d, out %d, ws %zu < %zu); nothing launched\n", n_in, n_in > 0 ? in_sizes[0] : -1, out_size, ws_size, (size_t)WS_END); grid = -1; return; }
        int dev = 0, cus = 0, per_cu = 0;
        if (hipGetDevice(&dev) != hipSuccess || hipDeviceGetAttribute(&cus, hipDeviceAttributeMultiprocessorCount, dev) != hipSuccess) { fprintf(stderr, "kernel_launch: device query failed\n"); grid = -1; return; }
        if (hipFuncSetAttribute((const void*)fwd, hipFuncAttributeMaxDynamicSharedMemorySize, LDS_BYTES) != hipSuccess) { fprintf(stderr, "kernel_launch: hipFuncSetAttribute failed\n"); grid = -1; return; }
        if (hipOccupancyMaxActiveBlocksPerMultiprocessor(&per_cu, (const void*)fwd, NWAVES * 64, LDS_BYTES) != hipSuccess || per_cu < 1) fprintf(stderr, "kernel_launch: note: occupancy query reports %d workgroups per CU\n", per_cu);
        (void)hipGetLastError();
        grid = cus;
    }
    if (grid < 0) return;
    if (hipMemsetAsync((char*)d_ws + WS_CTL, 0, CTL_ZERO_BYTES, stream) != hipSuccess) { fprintf(stderr, "kernel_launch: memset failed\n"); return; }
    Args a{};
    for (int i = 0; i < 17; ++i) a.in[i] = (const float*)d_in[i];
    a.out = (float*)d_out; a.ws = (unsigned char*)d_ws;
#if ONE_LAUNCH
    a.ph_lo = 0; a.ph_hi = NPH;
    hipLaunchKernelGGL(fwd, dim3(grid), dim3(NWAVES * 64), LDS_BYTES, stream, a);
#else
    for (int k = 0; k < NPH; ++k) { a.ph_lo = k; a.ph_hi = k + 1; for (int r = 0; r < (k == PROBE_REP ? 2 : 1); ++r) { if (r == 1 && PROBE_RESETQ) (void)hipMemsetAsync((char*)d_ws + CW_AQ * 4, 0, 4, stream); hipLaunchKernelGGL(fwd, dim3(grid), dim3(NWAVES * 64), LDS_BYTES, stream, a); } }
#endif
#if PROBE_X
    a.ph_lo = 10 + PROBE_X; a.ph_hi = 11 + PROBE_X; hipLaunchKernelGGL(fwd, dim3(grid), dim3(NWAVES * 64), LDS_BYTES, stream, a);
#endif
    const hipError_t le = hipPeekAtLastError();
    if (le != hipSuccess) fprintf(stderr, "kernel_launch: launch failed: %s\n", hipGetErrorName(le));
}
```

```cpp
#include <hip/hip_runtime.h>
#include <cstdio>
#include <cstdint>

#ifndef ONE_LAUNCH
#define ONE_LAUNCH 1
#endif
#ifndef PROBE_X
#define PROBE_X 0
#endif
#ifndef PROBE_RESETQ
#define PROBE_RESETQ 0
#endif
#ifndef DEFER_AT
#define DEFER_AT 5
#endif
#ifndef PROBE_BARS
#define PROBE_BARS 0
#endif
#ifndef QORDER
#define QORDER 1
#endif
#ifndef PROBE_REP
#define PROBE_REP -1
#endif

constexpr int M = 8192, SEQ = 2048, D = 4096, FF = 11008, NPROJ = 14368, NPROJ_MAIN = 14336, NH = 16, HD = 128;
constexpr int PJ_Q = 0, PJ_K = 2048, PJ_V = 4096, PJ_DQKV = 6144, PJ_DZ = 12288;
constexpr int LDD = D + 64, LDF = FF + 64, LDP = NPROJ_MAIN + 64;
constexpr float FIXS = 16777216.0f;
constexpr float EPS = 1e-6f;

__device__ __forceinline__ int fresh_lane() { int l; asm volatile("v_mbcnt_lo_u32_b32 %0, -1, 0\n\tv_mbcnt_hi_u32_b32 %0, -1, %0" : "=v"(l)); return l; }

namespace pg8 {
#define PG8_LAS __attribute__((address_space(3)))
typedef unsigned short bf16_t;
typedef short bf16x8 __attribute__((ext_vector_type(8)));
typedef float f32x4 __attribute__((ext_vector_type(4)));
typedef unsigned u32x4 __attribute__((ext_vector_type(4)));
constexpr int BM = 256, BK = 64, HALF = 128, HTB = HALF * BK * 2  , STAGE_BYTES = 8 * HTB, NXCD = 8, WGM = 8;

__host__ __device__ __forceinline__ int lds_byte(int r, int c) { const int st = (r >> 4) * 2 + (c >> 5), rr = r & 15, cc = c & 31, ob = rr * 64 + cc * 2; return st * 1024 + (ob ^ (((ob >> 9) & 1) << 5)); }
__host__ __device__ __forceinline__ void stage_rc(int b, int& R, int& C) { const int st = b / 1024, sb = b % 1024, swz = sb ^ (((sb >> 9) & 1) << 5); R = (st >> 1) * 16 + swz / 64; C = (st & 1) * 32 + (swz % 64) / 2; }
__host__ __device__ __forceinline__ int perm32(int rho) { const int n = rho >> 4, i = rho & 15; return 8 * (i >> 2) + 4 * n + (i & 3); }

struct Unit { int pm, pn; };
struct Gemm { const bf16_t* A; const bf16_t* Bt; int M, N, K, lda, ldb; };

struct StaticOrder {
    int nM, nN, nwg, G, c;
    __host__ __device__ void init(int M, int N, int G_, int c_) { nM = M / BM; nN = N / BM; nwg = nM * nN; G = G_; c = c_; }
    __host__ __device__ bool next(int i, Unit& u) const {
        const long L = (long)i * G + c; if (L >= nwg) return false;
        int wgid = (int)L; { const int q = nwg / NXCD, r = nwg % NXCD, xcd = wgid % NXCD, off = wgid / NXCD; wgid = (xcd < r ? xcd * (q + 1) : r * (q + 1) + (xcd - r) * q) + off; }
        const int nig = WGM * nN, gid = wgid / nig, fm = gid * WGM, gsz = (nM - fm) < WGM ? (nM - fm) : WGM;
        u.pm = fm + ((wgid % nig) % gsz); u.pn = (wgid % nig) / gsz; return true;
    }
    __device__ __forceinline__ void a_ready(const Unit&) const {}
    __device__ __forceinline__ void done(const Unit&) const {}
};

__device__ __forceinline__ unsigned cvt_pk_bf16(float lo, float hi) { unsigned r; asm volatile("v_cvt_pk_bf16_f32 %0, %1, %2" : "=v"(r) : "v"(lo), "v"(hi)); return r; }
typedef float f32x2 __attribute__((ext_vector_type(2)));

__device__ __forceinline__ float rstd_of(const unsigned long long* ssq, int row) {
    const unsigned long long q = ssq[row];
    const float s = (float)q * (1.0f / FIXS);
    return rsqrtf(s * (1.0f / (float)D) + EPS);
}
__device__ __forceinline__ float silu_f(float x) { return x * __builtin_amdgcn_rcpf(1.0f + __expf(-x)); }

struct EpiGateUp {
    static constexpr bool PERM = true, AFTER_DRAIN = false;
    bf16_t* O; const unsigned long long* ssq;
    __device__ __forceinline__ void operator()(const f32x4 (&acc)[2][2][4][2], const Unit& u, int wr, int wc, int fr, int fq) const {
        const int row0 = u.pm * BM + wr * 64 + fr, col0 = u.pn * HALF + wc * 32 + 8 * fq;
#pragma unroll
        for (int ai = 0; ai < 2; ++ai)
#pragma unroll
            for (int m = 0; m < 4; ++m) {
                const int row = row0 + ai * HALF + m * 16; const float rs = rstd_of(ssq, row);
                const f32x4 g0 = acc[ai][0][m][0] * rs, g1 = acc[ai][0][m][1] * rs, u0 = acc[ai][1][m][0] * rs, u1 = acc[ai][1][m][1] * rs;
                u32x4 w;
                w.x = cvt_pk_bf16(silu_f(g0[0]) * u0[0], silu_f(g0[1]) * u0[1]); w.y = cvt_pk_bf16(silu_f(g0[2]) * u0[2], silu_f(g0[3]) * u0[3]);
                w.z = cvt_pk_bf16(silu_f(g1[0]) * u1[0], silu_f(g1[1]) * u1[1]); w.w = cvt_pk_bf16(silu_f(g1[2]) * u1[2], silu_f(g1[3]) * u1[3]);
                *(u32x4*)(O + (size_t)row * LDF + col0) = w;
            }
    }
};
template <bool WRITE_XB, bool WRITE_F32 = true> struct EpiResid {
    static constexpr bool PERM = true, AFTER_DRAIN = false;
    const float* R; float* Of; bf16_t* XB; unsigned long long* ssq; float scale;
    __device__ __forceinline__ void operator()(const f32x4 (&acc)[2][2][4][2], const Unit& u, int wr, int wc, int fr, int fq) const {
        const int row0 = u.pm * BM + wr * 64 + fr, col0 = u.pn * BM + wc * 32 + 8 * fq;
#pragma unroll
        for (int ai = 0; ai < 2; ++ai)
#pragma unroll
            for (int m = 0; m < 4; ++m) {
                const int row = row0 + ai * HALF + m * 16; const size_t off = (size_t)row * D + col0; float ss = 0.f;
#pragma unroll
                for (int bj = 0; bj < 2; ++bj) {
                    const f32x4 r0 = *(const f32x4*)(R + off + bj * HALF), r1 = *(const f32x4*)(R + off + bj * HALF + 4);
                    const f32x4 h0 = r0 + acc[ai][bj][m][0] * scale, h1 = r1 + acc[ai][bj][m][1] * scale;
                    if (WRITE_F32) { *(f32x4*)(Of + off + bj * HALF) = h0; *(f32x4*)(Of + off + bj * HALF + 4) = h1; }
                    if (WRITE_XB) { u32x4 w; w.x = cvt_pk_bf16(h0[0], h0[1]); w.y = cvt_pk_bf16(h0[2], h0[3]); w.z = cvt_pk_bf16(h1[0], h1[1]); w.w = cvt_pk_bf16(h1[2], h1[3]);
                        *(u32x4*)(XB + (size_t)row * LDD + col0 + bj * HALF) = w; }
                    ss += (h0[0] * h0[0] + h0[1] * h0[1]) + (h0[2] * h0[2] + h0[3] * h0[3]) + (h1[0] * h1[0] + h1[1] * h1[1]) + (h1[2] * h1[2] + h1[3] * h1[3]);
                }
                ss += __shfl_xor(ss, 16); ss += __shfl_xor(ss, 32);
                if (fq == 0) __hip_atomic_fetch_add(ssq + row, (unsigned long long)(ss * FIXS), __ATOMIC_RELAXED, __HIP_MEMORY_SCOPE_AGENT);
                asm volatile("" ::: "memory");
            }
    }
};
struct EpiProj {
    static constexpr bool PERM = true, AFTER_DRAIN = false;
    bf16_t* O; const unsigned long long* ssq;
    __device__ __forceinline__ void operator()(const f32x4 (&acc)[2][2][4][2], const Unit& u, int wr, int wc, int fr, int fq) const {
        const int row0 = u.pm * BM + wr * 64 + fr, col0 = u.pn * BM + wc * 32 + 8 * fq;
#pragma unroll
        for (int ai = 0; ai < 2; ++ai)
#pragma unroll
            for (int m = 0; m < 4; ++m) {
                const int row = row0 + ai * HALF + m * 16; const float rs = rstd_of(ssq, row);
#pragma unroll
                for (int bj = 0; bj < 2; ++bj) { const f32x4 v0 = acc[ai][bj][m][0] * rs, v1 = acc[ai][bj][m][1] * rs;
                    u32x4 w; w.x = cvt_pk_bf16(v0[0], v0[1]); w.y = cvt_pk_bf16(v0[2], v0[3]); w.z = cvt_pk_bf16(v1[0], v1[1]); w.w = cvt_pk_bf16(v1[2], v1[3]);
                    *(u32x4*)(O + (size_t)row * LDP + col0 + bj * HALF) = w; }
            }
    }
};

struct EpiNull {
    static constexpr bool PERM = true, AFTER_DRAIN = false;
    float* sink;
    __device__ __forceinline__ void operator()(const f32x4 (&acc)[2][2][4][2], const Unit& u, int wr, int wc, int fr, int fq) const {
        float s = 0.f;
#pragma unroll
        for (int ai = 0; ai < 2; ++ai)
#pragma unroll
            for (int bj = 0; bj < 2; ++bj)
#pragma unroll
                for (int m = 0; m < 4; ++m)
#pragma unroll
                    for (int n = 0; n < 2; ++n) s += (acc[ai][bj][m][n][0] + acc[ai][bj][m][n][1]) + (acc[ai][bj][m][n][2] + acc[ai][bj][m][n][3]);
        if (s == 123456.789f) sink[u.pm * 64 + fr] = s;
    }
};
struct MaskOrder : StaticOrder {
    int mm, mn;
    __host__ __device__ bool next(int i, Unit& u) const { const bool ok = StaticOrder::next(i, u); u.pm &= mm; u.pn &= mn; return ok; }
};

#ifndef PG8_B_AUX
#define PG8_B_AUX 0
#endif
template <class Epi, class Sched, bool ALIGN_EPI = false, bool SP2 = false>
__device__ __forceinline__ void gemm_phase(PG8_LAS unsigned char* lds, const Gemm g, const Sched& S, const Epi& E, int wid) {
    const int lane = fresh_lane(), tid = wid * 64 + lane, wr = wid >> 2, wc = wid & 3, fr = lane & 15, fq = lane >> 4;
    const int K = g.K, nt = K / BK;
    unsigned voffA[2], voffB[2];
#pragma unroll
    for (int i = 0; i < 2; ++i) { int R, C; stage_rc(tid * 16 + i * 8192, R, C); const int Rb = Epi::PERM ? ((R & ~31) + perm32(R & 31)) : R;
        voffA[i] = (unsigned)(R * g.lda + C) * 2u; voffB[i] = (unsigned)(Rb * g.ldb + C) * 2u; }
    const size_t kstep = (size_t)(BK * 2);
    const size_t hstepA = (size_t)HALF * g.lda * 2, hstepB = (size_t)HALF * g.ldb * 2;
    const size_t tstepA = 2 * hstepA, tstepB = 2 * hstepB;
    const unsigned ldsw = (unsigned)wid * 1024u;
    const int aoff = lds_byte(wr * 64 + fr, fq * 8), boff = lds_byte(wc * 32 + fr, fq * 8);
#define PG8_SA(b, h) (((b) * 2 + (h)) * HTB)
#define PG8_SB(b, h) ((4 + (b) * 2 + (h)) * HTB)
#define PG8_STAGE(bufoff, gbase, voff) do { _Pragma("unroll") for (int _i = 0; _i < 2; ++_i) \
        __builtin_amdgcn_global_load_lds((const unsigned*)((const char*)(gbase) + (voff)[_i]), (PG8_LAS unsigned*)(lds + (bufoff) + ldsw + _i * 8192), 16, 0, 0); } while (0)
#define PG8_STAGE_NT(bufoff, gbase, voff) do { _Pragma("unroll") for (int _i = 0; _i < 2; ++_i) \
        __builtin_amdgcn_global_load_lds((const unsigned*)((const char*)(gbase) + (voff)[_i]), (PG8_LAS unsigned*)(lds + (bufoff) + ldsw + _i * 8192), 16, 0, PG8_B_AUX); } while (0)
#define PG8_LDA(dst, b, h) do { _Pragma("unroll") for (int m = 0; m < 4; ++m) _Pragma("unroll") for (int k = 0; k < 2; ++k) dst[m][k] = *(const PG8_LAS bf16x8*)(lds + PG8_SA(b, h) + aoff + m * 2048 + k * 1024); } while (0)
#define PG8_LDB(dst, b, h) do { _Pragma("unroll") for (int n = 0; n < 2; ++n) _Pragma("unroll") for (int k = 0; k < 2; ++k) dst[n][k] = *(const PG8_LAS bf16x8*)(lds + PG8_SB(b, h) + boff + n * 2048 + k * 1024); } while (0)
#define PG8_MMA(ai, bj, At, Bt) do { __builtin_amdgcn_s_setprio(1); _Pragma("unroll") for (int m = 0; m < 4; ++m) _Pragma("unroll") for (int n = 0; n < 2; ++n) _Pragma("unroll") for (int k = 0; k < 2; ++k) \
        acc[ai][bj][m][n] = __builtin_amdgcn_mfma_f32_16x16x32_bf16(Bt[n][k], At[m][k], acc[ai][bj][m][n], 0, 0, 0); __builtin_amdgcn_s_setprio(0); } while (0)
#define PG8_WAIT_V(n) asm volatile("s_waitcnt vmcnt(" #n ")" ::: "memory")
#define PG8_WAIT_L(n) asm volatile("s_waitcnt lgkmcnt(" #n ")" ::: "memory")
#define PG8_BAR __builtin_amdgcn_s_barrier()
#define PG8_SCHED __builtin_amdgcn_sched_barrier(0)
    Unit cur, nxt; int ui = 0;
    if (!S.next(0, cur)) return;
    f32x4 acc[2][2][4][2];
#pragma unroll
    for (int a = 0; a < 2; ++a)
#pragma unroll
        for (int b = 0; b < 2; ++b)
#pragma unroll
            for (int m = 0; m < 4; ++m)
#pragma unroll
                for (int n = 0; n < 2; ++n) acc[a][b][m][n] = (f32x4){0.f, 0.f, 0.f, 0.f};
    bf16x8 At[4][2], B0[2][2], B1[2][2];
    const char* cA = (const char*)g.A + (size_t)cur.pm * tstepA; const char* cB = (const char*)g.Bt + (size_t)cur.pn * tstepB;
    S.a_ready(cur);
    if constexpr (SP2) {
        PG8_STAGE_NT(PG8_SB(0, 0), cB, voffB); PG8_STAGE_NT(PG8_SB(0, 1), cB + hstepB, voffB); PG8_STAGE(PG8_SA(0, 0), cA, voffA); PG8_STAGE(PG8_SA(0, 1), cA + hstepA, voffA);
        if (wr == 1) PG8_BAR;
        PG8_WAIT_V(2); PG8_BAR;
        PG8_STAGE_NT(PG8_SB(1, 0), cB + kstep, voffB); PG8_STAGE(PG8_SA(1, 0), cA + kstep, voffA); PG8_STAGE_NT(PG8_SB(1, 1), cB + hstepB + kstep, voffB);
        PG8_WAIT_V(6); PG8_BAR;
    } else {
        PG8_STAGE_NT(PG8_SB(0, 0), cB, voffB); PG8_STAGE(PG8_SA(0, 0), cA, voffA); PG8_STAGE_NT(PG8_SB(0, 1), cB + hstepB, voffB); PG8_STAGE(PG8_SA(0, 1), cA + hstepA, voffA);
        if (wr == 1) PG8_BAR;
        PG8_WAIT_V(4); PG8_BAR;
        PG8_STAGE_NT(PG8_SB(1, 0), cB + kstep, voffB); PG8_STAGE(PG8_SA(1, 0), cA + kstep, voffA); PG8_STAGE_NT(PG8_SB(1, 1), cB + hstepB + kstep, voffB);
        PG8_WAIT_V(6); PG8_BAR;
    }
    for (;;) {
        const bool has_next = S.next(ui + 1, nxt);
        const char* nA = has_next ? (const char*)g.A + (size_t)nxt.pm * tstepA : cA; const char* nB = has_next ? (const char*)g.Bt + (size_t)nxt.pn * tstepB : cB;
        for (int t = 0; t < nt; t += 2) {
            const bool last = (t == nt - 2);
            const char* a1 = cA + (size_t)(t + 1) * kstep;
            const char* a2 = last ? nA : cA + (size_t)(t + 2) * kstep; const char* b2 = last ? nB : cB + (size_t)(t + 2) * kstep;
            const char* a3 = a2 + kstep; const char* b3 = b2 + kstep;
            if (last && has_next) S.a_ready(nxt);
            if constexpr (SP2) {
            PG8_LDB(B0, 0, 0); PG8_LDB(B1, 0, 1); PG8_SCHED; PG8_LDA(At, 0, 0); PG8_STAGE(PG8_SA(1, 1), a1 + hstepA, voffA);
            PG8_WAIT_V(8); PG8_WAIT_L(0); PG8_BAR; PG8_MMA(0, 0, At, B0); PG8_MMA(0, 1, At, B1); PG8_BAR; PG8_SCHED;
            PG8_LDA(At, 0, 1); PG8_STAGE_NT(PG8_SB(0, 0), b2, voffB); PG8_STAGE_NT(PG8_SB(0, 1), b2 + hstepB, voffB); PG8_STAGE(PG8_SA(0, 0), a2, voffA);
            PG8_WAIT_V(8); PG8_WAIT_L(0); PG8_BAR; PG8_MMA(1, 0, At, B0); PG8_MMA(1, 1, At, B1); PG8_BAR; PG8_SCHED;
            PG8_LDB(B0, 1, 0); PG8_LDB(B1, 1, 1); PG8_SCHED; PG8_LDA(At, 1, 0); PG8_STAGE(PG8_SA(0, 1), a2 + hstepA, voffA);
            PG8_WAIT_V(8); PG8_WAIT_L(0); PG8_BAR; PG8_MMA(0, 0, At, B0); PG8_MMA(0, 1, At, B1); PG8_BAR; PG8_SCHED;
            PG8_LDA(At, 1, 1); PG8_STAGE_NT(PG8_SB(1, 0), b3, voffB); PG8_STAGE_NT(PG8_SB(1, 1), b3 + hstepB, voffB); PG8_STAGE(PG8_SA(1, 0), a3, voffA);
            PG8_WAIT_V(8); PG8_WAIT_L(0); PG8_BAR; PG8_MMA(1, 0, At, B0); PG8_MMA(1, 1, At, B1); PG8_BAR; PG8_SCHED;
            } else {
            PG8_LDB(B0, 0, 0); PG8_SCHED; PG8_LDA(At, 0, 0); PG8_STAGE(PG8_SA(1, 1), a1 + hstepA, voffA);
            PG8_WAIT_L(8); PG8_BAR; PG8_WAIT_L(0); PG8_MMA(0, 0, At, B0); PG8_BAR; PG8_SCHED;
            PG8_LDB(B1, 0, 1); PG8_STAGE_NT(PG8_SB(0, 0), b2, voffB);
            PG8_BAR; PG8_WAIT_L(0); PG8_MMA(0, 1, At, B1); PG8_BAR;
            PG8_LDA(At, 0, 1); PG8_STAGE(PG8_SA(0, 0), a2, voffA);
            PG8_BAR; PG8_WAIT_L(0); PG8_MMA(1, 0, At, B0); PG8_BAR; PG8_SCHED;
            PG8_STAGE_NT(PG8_SB(0, 1), b2 + hstepB, voffB);
            PG8_WAIT_V(6); PG8_BAR; PG8_MMA(1, 1, At, B1); PG8_BAR;
            PG8_LDB(B0, 1, 0); PG8_SCHED; PG8_LDA(At, 1, 0); PG8_STAGE(PG8_SA(0, 1), a2 + hstepA, voffA);
            PG8_WAIT_L(8); PG8_BAR; PG8_WAIT_L(0); PG8_MMA(0, 0, At, B0); PG8_BAR; PG8_SCHED;
            PG8_LDB(B1, 1, 1); PG8_STAGE_NT(PG8_SB(1, 0), b3, voffB);
            PG8_BAR; PG8_WAIT_L(0); PG8_MMA(0, 1, At, B1); PG8_BAR;
            PG8_LDA(At, 1, 1); PG8_STAGE(PG8_SA(1, 0), a3, voffA);
            PG8_BAR; PG8_WAIT_L(0); PG8_MMA(1, 0, At, B0); PG8_BAR; PG8_SCHED;
            PG8_STAGE_NT(PG8_SB(1, 1), b3 + hstepB, voffB);
            PG8_WAIT_V(6); PG8_BAR; PG8_MMA(1, 1, At, B1); PG8_BAR;
            }
        }
        if constexpr (ALIGN_EPI) { if (wr == 0) PG8_BAR; }
        if constexpr (!Epi::AFTER_DRAIN) { E(acc, cur, wr, wc, fr, fq); S.done(cur); }
        if (!has_next) break;
#pragma unroll
        for (int a = 0; a < 2; ++a)
#pragma unroll
            for (int b = 0; b < 2; ++b)
#pragma unroll
                for (int m = 0; m < 4; ++m)
#pragma unroll
                    for (int n = 0; n < 2; ++n) acc[a][b][m][n] = (f32x4){0.f, 0.f, 0.f, 0.f};
        cur = nxt; cA = nA; cB = nB; ++ui;
        if constexpr (ALIGN_EPI) { if (wr == 1) PG8_BAR; }
    }
    PG8_WAIT_V(0);
    if constexpr (!ALIGN_EPI) { if (wr == 0) PG8_BAR; }
    PG8_BAR;
    if constexpr (Epi::AFTER_DRAIN) { E.fused(acc, cur, wr, wc, fr, fq, lds, wid, lane); S.done(cur); }
#undef PG8_SA
#undef PG8_SB
#undef PG8_STAGE
#undef PG8_STAGE_NT
#undef PG8_LDA
#undef PG8_LDB
#undef PG8_MMA
#undef PG8_WAIT_V
#undef PG8_WAIT_L
#undef PG8_BAR
#undef PG8_SCHED
}
}

constexpr size_t MiB = 1u << 20;
constexpr size_t WS_CTL = 0, CTL_ZERO_BYTES = 1 * MiB;
constexpr size_t WS_SSQ = 256 * 1024;
constexpr size_t WS_BETA = 2 * MiB, WS_G = WS_BETA + 512 * 1024, WS_GL = 3 * MiB;
constexpr size_t WS_WGU1 = 4 * MiB, WS_WD1 = WS_WGU1 + 176 * MiB, WS_WIN = WS_WD1 + 88 * MiB, WS_WOUT = WS_WIN + 115 * MiB, WS_WGU2 = WS_WOUT + 33 * MiB, WS_WD2 = WS_WGU2 + 176 * MiB;
constexpr size_t WS_XB = WS_WD2 + 88 * MiB;
constexpr size_t WS_ACT = WS_XB + 66 * MiB;
constexpr size_t WS_PROJ = WS_ACT + 174 * MiB;
constexpr size_t WS_CONCAT = WS_PROJ + 226 * MiB;
constexpr size_t WS_QN = WS_CONCAT + 66 * MiB, WS_KN = WS_QN + 32 * MiB, WS_VN = WS_KN + 32 * MiB;
constexpr size_t WS_ORAW = WS_VN + 32 * MiB;
constexpr size_t WS_END = WS_ORAW + 64 * MiB;
static_assert((size_t)2048 * 59904 <= 174 * MiB && (size_t)2 * FF * LDD * 2 <= 176 * MiB && (size_t)D * LDF * 2 <= 88 * MiB && (size_t)NPROJ * LDD * 2 <= 115 * MiB && (size_t)D * LDD * 2 <= 33 * MiB && (size_t)M * LDD * 2 <= 66 * MiB && (size_t)M * LDF * 2 <= 174 * MiB && (size_t)M * LDP * 2 <= 226 * MiB, "d_ws map");
constexpr int CW_BAR = 4096;
constexpr int CW_AQ = 8192;

constexpr int RING_BYTES = 131072;
constexpr int P0_SCR_BYTES = 8 * 64 * 65 * 4;
constexpr int LDSCTL_OFF = 163328, MISC_OFF = LDSCTL_OFF + 320;
constexpr int LDS_BYTES = 163840;
static_assert(P0_SCR_BYTES <= LDSCTL_OFF && MISC_OFF + 128 <= LDS_BYTES, "LDS map");

#define GAS __attribute__((address_space(1)))
#define LAS __attribute__((address_space(3)))
typedef unsigned short bf16;
typedef float f32x4 __attribute__((ext_vector_type(4)));
typedef float f32x2 __attribute__((ext_vector_type(2)));
typedef float f32x16 __attribute__((ext_vector_type(16)));
typedef unsigned u32x4 __attribute__((ext_vector_type(4)));
typedef unsigned u32x2 __attribute__((ext_vector_type(2)));
typedef short bf16x8 __attribute__((ext_vector_type(8)));
constexpr int NWAVES = 8;

__device__ __forceinline__ unsigned pk2(float lo, float hi) { return pg8::cvt_pk_bf16(lo, hi); }
__device__ __forceinline__ float bf_lo(unsigned w) { return __uint_as_float(w << 16); }
__device__ __forceinline__ float bf_hi(unsigned w) { return __uint_as_float(w & 0xffff0000u); }
__device__ __forceinline__ float bf2f(bf16 v) { return __uint_as_float(((unsigned)v) << 16); }
__device__ __forceinline__ float wave_sum(float v) {
#pragma unroll
    for (int o = 1; o < 64; o <<= 1) v += __shfl_xor(v, o);
    return v;
}
__device__ __forceinline__ float wave_max(float v) {
#pragma unroll
    for (int o = 1; o < 64; o <<= 1) v = fmaxf(v, __shfl_xor(v, o));
    return v;
}

#define XB_TMO      128
#define XB_XCNT(j)  (256  + 64 * (j))
#define XB_XSUB(j)  (1280 + 64 * (j))
#define XB_XGEN(j)  (2304 + 64 * (j))
#define XB_TOP      3328
#define XB_TOPGEN   3392
#define XCD_BAR_WORDS 3456
#define XB_SPIN_CAP (1u << 18)

__device__ __forceinline__ unsigned xb_ld(unsigned* p)              { return __hip_atomic_load(p, __ATOMIC_RELAXED, __HIP_MEMORY_SCOPE_AGENT); }
__device__ __forceinline__ unsigned xb_add(unsigned* p, unsigned v) { return __hip_atomic_fetch_add(p, v, __ATOMIC_RELAXED, __HIP_MEMORY_SCOPE_AGENT); }
__device__ __forceinline__ unsigned xb_xcc_id() { return (unsigned)__builtin_amdgcn_s_getreg((3 << 11) | 20) & 0xFu; }
#define XB_SPIN(cond, bar) do { unsigned _sp = 0; while (cond) { __builtin_amdgcn_s_sleep(1); \
    if ((++_sp & 255u) == 0u) { if (xb_ld(&(bar)[XB_TMO])) break; if (_sp > XB_SPIN_CAP) { atomicAdd(&(bar)[XB_TMO], 1u); break; } } } } while (0)

struct XcdBarrier {
    unsigned* bar; unsigned x;
    volatile LAS unsigned* st;
    int w;
};

__device__ __forceinline__ XcdBarrier xcd_barrier_post(unsigned* bar, volatile LAS unsigned* st) {
    XcdBarrier b; b.bar = bar; b.x = xb_xcc_id(); b.st = st;
    if (threadIdx.x == 0) (void)xb_add(&bar[XB_XCNT(b.x)], 1u);
    return b;
}
__device__ __forceinline__ void xcd_barrier_complete(unsigned* bar, unsigned x, unsigned& nloc, unsigned& nx) {
    const unsigned G = gridDim.x * gridDim.y * gridDim.z;
    unsigned sum, cnt, mine, sp = 0u;
    for (;;) {
        sum = 0u; cnt = 0u; mine = 0u;
#pragma unroll
        for (unsigned j = 0; j < 16; ++j) { const unsigned c = xb_ld(&bar[XB_XCNT(j)]); sum += c; cnt += (c > 0u) ? 1u : 0u; mine = (j == x) ? c : mine; }
        if (sum == G) break;
        __builtin_amdgcn_s_sleep(1);
        if ((++sp & 255u) == 0u) { if (xb_ld(&bar[XB_TMO])) break; if (sp > XB_SPIN_CAP) { atomicAdd(&bar[XB_TMO], 1u); break; } }
    }
    nloc = mine > 0u ? mine : 1u; nx = cnt > 0u ? cnt : 1u;
}

__device__ __forceinline__ void xcd_barrier(const XcdBarrier& b) {
    asm volatile("s_waitcnt vmcnt(0)" ::: "memory");
    __syncthreads();
    if (b.w == 0 && fresh_lane() == 0) {
        unsigned* bar = b.bar;
        __builtin_amdgcn_s_waitcnt(0);
        unsigned nloc = b.st[0], nx = b.st[1];
        if (nloc == 0u) { xcd_barrier_complete(bar, b.x, nloc, nx); b.st[0] = nloc; b.st[1] = nx; }
        const unsigned old = xb_add(&bar[XB_XSUB(b.x)], 1u);
        const unsigned gen = old / nloc;
        if (old + 1u == (gen + 1u) * nloc) {
            __builtin_amdgcn_fence(__ATOMIC_RELEASE, "agent");
            asm volatile("s_waitcnt vmcnt(0)" ::: "memory");
            const unsigned og = xb_add(&bar[XB_TOP], 1u);
            const unsigned tg = og / nx;
            if (og + 1u == (tg + 1u) * nx) xb_add(&bar[XB_TOPGEN], 1u);
            else XB_SPIN(xb_ld(&bar[XB_TOPGEN]) == tg, bar);
            __builtin_amdgcn_fence(__ATOMIC_ACQUIRE, "agent");
            xb_add(&bar[XB_XGEN(b.x)], 1u);
            asm volatile("s_waitcnt vmcnt(0)" ::: "memory");
        } else {
            XB_SPIN(xb_ld(&bar[XB_XGEN(b.x)]) == gen, bar);
            __builtin_amdgcn_fence(__ATOMIC_ACQUIRE, "agent");
            asm volatile("s_waitcnt vmcnt(0)" ::: "memory");
        }
    }
    __syncthreads();
}

#define P0T_DECL(x) const float* x##W = nullptr; const float* x##G = nullptr; bf16* x##T = nullptr; int x##K = 0, x##N = 0, x##k0 = 0, x##n0 = 0, x##ld = 0, x##blk = 0, x##off = 0
__device__ __forceinline__ void p0_load(const float* W, int N, int k0, int n0, int lane, f32x4 (&v)[16]) {
    const int c = lane & 15, rq = lane >> 4;
    int col = n0 + 4 * c; col = col < N - 4 ? col : N - 4;
    const float* p = W + (size_t)(k0 + rq) * N + col;
#pragma unroll
    for (int j = 0; j < 16; ++j) v[j] = __builtin_nontemporal_load((const f32x4*)(p + (size_t)(4 * j) * N));
}
__device__ __forceinline__ void p0_finish(bf16* WT, const float* gain, int N, int k0, int n0, int ldw, int blk, int off, int lane, const f32x4 (&v)[16], LAS float* scr) {
    const int c = lane & 15, rq = lane >> 4, c8 = lane & 7;
    f32x4 g0 = {1.f, 1.f, 1.f, 1.f}, g1 = g0;
    if (gain) { g0 = *(const f32x4*)(gain + k0 + 8 * c8); g1 = *(const f32x4*)(gain + k0 + 8 * c8 + 4); }
#pragma unroll
    for (int j = 0; j < 16; ++j) { LAS float* s = scr + (4 * j + rq) * 65 + 4 * c; s[0] = v[j][0]; s[1] = v[j][1]; s[2] = v[j][2]; s[3] = v[j][3]; }
    asm volatile("s_waitcnt lgkmcnt(0)" ::: "memory");
#pragma unroll
    for (int jj = 0; jj < 8; ++jj) { const int n = (lane >> 3) + 8 * jj; const LAS float* s = scr + (8 * c8) * 65 + n;
        u32x4 o; o.x = pk2(s[0 * 65] * g0[0], s[1 * 65] * g0[1]); o.y = pk2(s[2 * 65] * g0[2], s[3 * 65] * g0[3]); o.z = pk2(s[4 * 65] * g1[0], s[5 * 65] * g1[1]); o.w = pk2(s[6 * 65] * g1[2], s[7 * 65] * g1[3]);
        const int ng = n0 + n;
        if (ng < N) { const int row = (ng >> 7) * blk + (ng & 127) + off; __builtin_nontemporal_store(o, (u32x4*)(WT + (size_t)row * ldw + k0 + 8 * c8)); } }
    asm volatile("s_waitcnt lgkmcnt(0)" ::: "memory");
}

constexpr int ATT_KS_BYTES = 32 * 272, ATT_VS_BYTES = ATT_KS_BYTES + 32 * 320;
static_assert(8 * ATT_VS_BYTES <= LDSCTL_OFF, "attention LDS");
typedef short v4i16_t __attribute__((ext_vector_type(4)));
typedef __bf16 bf16x2_t __attribute__((ext_vector_type(2)));
__device__ __forceinline__ unsigned cvtpk_c(float lo, float hi) { f32x2 v = {lo, hi}; bf16x2_t b = __builtin_convertvector(v, bf16x2_t); return __builtin_bit_cast(unsigned, b); }
__device__ __forceinline__ bf16x8 pack_step(const f32x16& x, int s) { u32x4 p; p.x = cvtpk_c(x[8 * s], x[8 * s + 1]); p.y = cvtpk_c(x[8 * s + 2], x[8 * s + 3]); p.z = cvtpk_c(x[8 * s + 4], x[8 * s + 5]); p.w = cvtpk_c(x[8 * s + 6], x[8 * s + 7]); return __builtin_bit_cast(bf16x8, p); }
__device__ __forceinline__ v4i16_t tr16(const LAS unsigned char* p) { return __builtin_amdgcn_ds_read_tr16_b64_v4i16((LAS v4i16_t*)p); }
__device__ __forceinline__ void att_tile(const LAS unsigned char* kb, const LAS unsigned char* vb, int k0, int lq, int i, int hh, int troff,
                                         const bf16x8 (&qf)[8], f32x16 (&oacc)[4], float& mrun, float& lrun) {
    constexpr float SC = 0.08838834764831845f * 1.4426950408889634f;
    f32x16 sacc, sacc2;
#pragma unroll
    for (int r = 0; r < 16; ++r) { sacc[r] = 0.f; sacc2[r] = 0.f; }
#pragma unroll
    for (int s = 0; s < 8; s += 2) { sacc = __builtin_amdgcn_mfma_f32_32x32x16_bf16(*(const LAS bf16x8*)(kb + i * 272 + 32 * s + 16 * hh), qf[s], sacc, 0, 0, 0);
        sacc2 = __builtin_amdgcn_mfma_f32_32x32x16_bf16(*(const LAS bf16x8*)(kb + i * 272 + 32 * (s + 1) + 16 * hh), qf[s + 1], sacc2, 0, 0, 0); }
#pragma unroll
    for (int r = 0; r < 16; ++r) sacc[r] += sacc2[r];
    float tmax = -1e30f;
    const int dbase = lq - k0 - 4 * hh;
#pragma unroll
    for (int r = 0; r < 16; ++r) { const unsigned dd = (unsigned)(dbase - ((r & 3) + 8 * (r >> 2)));
        const float sv = dd <= 128u ? sacc[r] * SC : -INFINITY; sacc[r] = sv; tmax = fmaxf(tmax, sv); }
    tmax = fmaxf(tmax, __shfl_xor(tmax, 32));
    const float mnew = fmaxf(mrun, tmax);
    const float alpha = __builtin_amdgcn_exp2f(mrun - mnew);
#pragma unroll
    for (int dt = 0; dt < 4; ++dt)
#pragma unroll
        for (int r = 0; r < 16; ++r) oacc[dt][r] *= alpha;
    float psum = 0.f;
#pragma unroll
    for (int r = 0; r < 16; ++r) { const float p = __builtin_amdgcn_exp2f(sacc[r] - mnew); sacc[r] = p; psum += p; }
    psum += __shfl_xor(psum, 32);
    lrun = lrun * alpha + psum; mrun = mnew;
    const bf16x8 pf0 = pack_step(sacc, 0), pf1 = pack_step(sacc, 1);
#pragma unroll
    for (int dt = 0; dt < 4; ++dt) {
        const LAS unsigned char* vp = vb + troff + dt * 64;
        const v4i16_t a0 = tr16(vp), a1 = tr16(vp + 8 * 320), a2 = tr16(vp + 16 * 320), a3 = tr16(vp + 24 * 320);
        const bf16x8 A0 = __builtin_shufflevector(a0, a1, 0, 1, 2, 3, 4, 5, 6, 7), A1 = __builtin_shufflevector(a2, a3, 0, 1, 2, 3, 4, 5, 6, 7);
        oacc[dt] = __builtin_amdgcn_mfma_f32_32x32x16_bf16(A0, pf0, oacc[dt], 0, 0, 0);
        oacc[dt] = __builtin_amdgcn_mfma_f32_32x32x16_bf16(A1, pf1, oacc[dt], 0, 0, 0);
    }
}
__device__ __forceinline__ void attn_wg(const bf16* PROJ, bf16* CONCAT, int wu, LAS unsigned char* L, int tid, int lane, int wave) {
    const int half = wu & 1, bh = (wu >> 1) & 63, blk = 3 - (wu >> 7), h = bh & 15, b = bh >> 4;
    const int rho = 4 * (wave & 3) + 2 * half + (wave >> 2);
    const int i = lane & 31, hh = lane >> 5, l0 = blk * 32;
    const int tq = 16 * (l0 + i) + rho;
    const size_t rowbase = (size_t)b * SEQ;
    bf16x8 qf[8];
    { const bf16* qp = PROJ + (rowbase + tq) * LDP + PJ_Q + h * HD + 8 * hh;
#pragma unroll
      for (int s = 0; s < 8; ++s) qf[s] = *(const bf16x8*)(qp + 16 * s); }
    f32x16 oacc[4];
#pragma unroll
    for (int dt = 0; dt < 4; ++dt)
#pragma unroll
        for (int r = 0; r < 16; ++r) oacc[dt][r] = 0.f;
    float mrun = -1e30f, lrun = 0.f;
    const int g16 = lane >> 4, i16 = lane & 15;
    const int troff = (4 * (g16 >> 1) + (i16 >> 2)) * 320 + (16 * (g16 & 1) + 4 * (i16 & 3)) * 2;
    const bf16* kbase = PROJ + rowbase * LDP + PJ_K + h * HD;
    const bf16* vbase = PROJ + rowbase * LDP + PJ_V + h * HD;
    constexpr int TILE = ATT_VS_BYTES;
    __syncthreads();
    { const int kA = 512 * blk - 128 > 0 ? 512 * blk - 128 : 0, nt = (512 * blk + 511 - kA) / 32 + 1;
      const int row = tid >> 4, ch = tid & 15, lq = tq;
      u32x4 kr, vr;
      { int tok = kA + row; tok = tok < SEQ - 1 ? tok : SEQ - 1; kr = *(const u32x4*)(kbase + (size_t)tok * LDP + 8 * ch); vr = *(const u32x4*)(vbase + (size_t)tok * LDP + 8 * ch); }
      *(LAS u32x4*)(L + row * 272 + 16 * ch) = kr; *(LAS u32x4*)(L + ATT_KS_BYTES + row * 320 + 16 * ch) = vr;
      __syncthreads();
      for (int j = 0; j < nt; ++j) {
          const bool more = j + 1 < nt;
          if (more) { int tok = kA + 32 * (j + 1) + row; tok = tok < SEQ - 1 ? tok : SEQ - 1; kr = *(const u32x4*)(kbase + (size_t)tok * LDP + 8 * ch); vr = *(const u32x4*)(vbase + (size_t)tok * LDP + 8 * ch); }
          const LAS unsigned char* tb = L + (j & 1) * TILE;
          att_tile(tb, tb + ATT_KS_BYTES, kA + 32 * j, lq, i, hh, troff, qf, oacc, mrun, lrun);
          if (more) { LAS unsigned char* nb = L + ((j + 1) & 1) * TILE; *(LAS u32x4*)(nb + row * 272 + 16 * ch) = kr; *(LAS u32x4*)(nb + ATT_KS_BYTES + row * 320 + 16 * ch) = vr; }
          __syncthreads();
      } }
    { const int kB = 4 * l0 - 128 > 0 ? 4 * l0 - 128 : 0, nt = (4 * l0 + 127 - kB) / 32 + 1;
      const int grp = wave >> 2, tg = tid & 255, row = tg >> 3, ch = 2 * (tg & 7), rd = rho & 3, lq = 4 * (l0 + i) + (rho >> 2);
      LAS unsigned char* gb = L + grp * 2 * TILE;
      u32x4 kr0, kr1, vr0, vr1;
      { int tok = ((kB + row) << 2) + rd; tok = tok < SEQ - 1 ? tok : SEQ - 1; const bf16* kp = kbase + (size_t)tok * LDP + 8 * ch; const bf16* vp = vbase + (size_t)tok * LDP + 8 * ch;
        kr0 = *(const u32x4*)kp; kr1 = *(const u32x4*)(kp + 8); vr0 = *(const u32x4*)vp; vr1 = *(const u32x4*)(vp + 8); }
      { LAS u32x4* kd = (LAS u32x4*)(gb + row * 272 + 16 * ch); kd[0] = kr0; kd[1] = kr1; LAS u32x4* vd = (LAS u32x4*)(gb + ATT_KS_BYTES + row * 320 + 16 * ch); vd[0] = vr0; vd[1] = vr1; }
      __syncthreads();
      for (int j = 0; j < nt; ++j) {
          const bool more = j + 1 < nt;
          if (more) { int tok = ((kB + 32 * (j + 1) + row) << 2) + rd; tok = tok < SEQ - 1 ? tok : SEQ - 1; const bf16* kp = kbase + (size_t)tok * LDP + 8 * ch; const bf16* vp = vbase + (size_t)tok * LDP + 8 * ch;
              kr0 = *(const u32x4*)kp; kr1 = *(const u32x4*)(kp + 8); vr0 = *(const u32x4*)vp; vr1 = *(const u32x4*)(vp + 8); }
          const LAS unsigned char* tb = gb + (j & 1) * TILE;
          att_tile(tb, tb + ATT_KS_BYTES, kB + 32 * j, lq, i, hh, troff, qf, oacc, mrun, lrun);
          if (more) { LAS unsigned char* nb = gb + ((j + 1) & 1) * TILE; LAS u32x4* kd = (LAS u32x4*)(nb + row * 272 + 16 * ch); kd[0] = kr0; kd[1] = kr1;
              LAS u32x4* vd = (LAS u32x4*)(nb + ATT_KS_BYTES + row * 320 + 16 * ch); vd[0] = vr0; vd[1] = vr1; }
          __syncthreads();
      } }
    { const int kC = l0 - 128 > 0 ? l0 - 128 : 0, nt = (l0 + 31 - kC) / 32 + 1, lq = l0 + i;
      LAS unsigned char* wb = L + wave * TILE;
      u32x4 kst[8], vst[8];
#define ATT_LOADC(K0) do { _Pragma("unroll") for (int jj_ = 0; jj_ < 8; ++jj_) { int tok_ = (((K0) + 4 * jj_ + g16) << 4) + rho; tok_ = tok_ < SEQ - 1 ? tok_ : SEQ - 1; \
        kst[jj_] = *(const u32x4*)(kbase + (size_t)tok_ * LDP + 8 * i16); vst[jj_] = *(const u32x4*)(vbase + (size_t)tok_ * LDP + 8 * i16); } } while (0)
      for (int j = 0; j < nt; ++j) {
          ATT_LOADC(kC + 32 * j);
#pragma unroll
          for (int jj = 0; jj < 8; ++jj) { *(LAS u32x4*)(wb + (4 * jj + g16) * 272 + i16 * 16) = kst[jj]; *(LAS u32x4*)(wb + ATT_KS_BYTES + (4 * jj + g16) * 320 + i16 * 16) = vst[jj]; }
          att_tile(wb, wb + ATT_KS_BYTES, kC + 32 * j, lq, i, hh, troff, qf, oacc, mrun, lrun);
      }
#undef ATT_LOADC
    }
    const float inv = 1.0f / lrun;
    bf16* op = CONCAT + (rowbase + tq) * LDD + h * HD + 4 * hh;
#pragma unroll
    for (int dt = 0; dt < 4; ++dt)
#pragma unroll
        for (int g = 0; g < 4; ++g) { u32x2 w; w.x = cvtpk_c(oacc[dt][4 * g] * inv, oacc[dt][4 * g + 1] * inv); w.y = cvtpk_c(oacc[dt][4 * g + 2] * inv, oacc[dt][4 * g + 3] * inv);
            *(u32x2*)(op + 32 * dt + 8 * g) = w; }
}

constexpr int DN_NW = 0, DN_QD = 16896, DN_QK = 33792, DN_KDT = 42496, DN_BLK = 59904;
constexpr int CL_KS = 0, CL_QS = 17408, CL_KT = 34816, CL_VT = 53248, CL_AS = 71680, CL_TW = 89088, CL_TU = 98304, CL_TB = 107520, CL_QK = 116736, CL_TT = 125440, CL_A10 = 128000, CL_GC = 130560, CL_END = 131072;
static_assert(CL_END <= LDSCTL_OFF && 2 * DN_BLK <= LDSCTL_OFF, "DeltaNet LDS maps");
__device__ __forceinline__ int crow16(int reg, int hh) { return (reg & 3) + 8 * (reg >> 2) + 4 * hh; }
__device__ __forceinline__ bf16x8 ld_perm(const LAS unsigned char* p) {
    const v4i16_t lo = *(const LAS v4i16_t*)p, hi = *(const LAS v4i16_t*)(p + 16); return __builtin_shufflevector(lo, hi, 0, 1, 2, 3, 4, 5, 6, 7); }

__device__ __forceinline__ void dn_chunk_local(int unit, const bf16* PROJ, const float* conv_w, const float* GLOG, const float* BETA, unsigned char* blocks, float* Ubuf, float* GL,
                                               LAS unsigned char* L, int tid, int lane, int wave) {
    asm volatile("" : "+v"(tid), "+v"(lane), "+s"(wave));
    const int n = unit & 31, bh = unit >> 5, h = bh & 15, b = bh >> 4, hh = lane >> 5;
    const int m0 = b * SEQ + 64 * n;
    unsigned char* blk = blocks + (size_t)unit * DN_BLK;
    LAS float* cws = (LAS float*)(L + CL_AS);
    LAS float* gcs = (LAS float*)(L + CL_GC); LAS float* betas = gcs + 64;
    for (int e = tid; e < 3 * 4 * 128; e += 512) { const int seg = e >> 9, tap = (e >> 7) & 3, ch = e & 127; cws[e] = conv_w[tap * 6144 + seg * 2048 + h * HD + ch]; }
    float gcv = GLOG[(size_t)(m0 + lane) * 16 + h];
#pragma unroll
    for (int o = 1; o < 64; o <<= 1) { const float t = __shfl_up(gcv, o); if (lane >= o) gcv += t; }
    const float gc_last = __shfl(gcv, 63);
    if (wave == 0) { gcs[lane] = gcv; betas[lane] = BETA[(size_t)(m0 + lane) * 16 + h]; }
    __syncthreads();
    { const int tt = tid >> 3, cg = tid & 7, t = 64 * n + tt;
      const float egc = __expf(__shfl(gcv, tt));
#pragma unroll
      for (int seg = 0; seg < 3; ++seg) {
          float a[16];
#pragma unroll
          for (int e = 0; e < 16; ++e) a[e] = 0.f;
#pragma unroll
          for (int tap = 0; tap < 4; ++tap) { if (t - 3 + tap >= 0) {
              const bf16* pr = PROJ + (size_t)(m0 + tt - 3 + tap) * LDP + PJ_DQKV + seg * 2048 + h * HD + 16 * cg;
              const u32x4 x0 = *(const u32x4*)pr, x1 = *(const u32x4*)(pr + 8);
              const LAS f32x4* w4 = (const LAS f32x4*)(cws + (seg * 4 + tap) * 128 + 16 * cg);
              const f32x4 w0 = w4[0], w1 = w4[1], w2 = w4[2], w3 = w4[3];
              a[0] += w0[0] * bf_lo(x0.x); a[1] += w0[1] * bf_hi(x0.x); a[2] += w0[2] * bf_lo(x0.y); a[3] += w0[3] * bf_hi(x0.y);
              a[4] += w1[0] * bf_lo(x0.z); a[5] += w1[1] * bf_hi(x0.z); a[6] += w1[2] * bf_lo(x0.w); a[7] += w1[3] * bf_hi(x0.w);
              a[8] += w2[0] * bf_lo(x1.x); a[9] += w2[1] * bf_hi(x1.x); a[10] += w2[2] * bf_lo(x1.y); a[11] += w2[3] * bf_hi(x1.y);
              a[12] += w3[0] * bf_lo(x1.z); a[13] += w3[1] * bf_hi(x1.z); a[14] += w3[2] * bf_lo(x1.w); a[15] += w3[3] * bf_hi(x1.w); } }
          float ss = 0.f;
#pragma unroll
          for (int e = 0; e < 16; ++e) { a[e] = pg8::silu_f(a[e]); ss += a[e] * a[e]; }
          if (seg < 2) { ss += __shfl_xor(ss, 1); ss += __shfl_xor(ss, 2); ss += __shfl_xor(ss, 4);
              const float rn = rsqrtf(ss + EPS) * (seg == 0 ? 0.08838834764831845f : 1.0f);
#pragma unroll
              for (int e = 0; e < 16; ++e) a[e] *= rn; }
          if (seg == 0) {
              u32x4 p0, p1; p0.x = cvtpk_c(a[0], a[1]); p0.y = cvtpk_c(a[2], a[3]); p0.z = cvtpk_c(a[4], a[5]); p0.w = cvtpk_c(a[6], a[7]);
              p1.x = cvtpk_c(a[8], a[9]); p1.y = cvtpk_c(a[10], a[11]); p1.z = cvtpk_c(a[12], a[13]); p1.w = cvtpk_c(a[14], a[15]);
              LAS u32x4* qd = (LAS u32x4*)(L + CL_QS + tt * 272 + 32 * cg); qd[0] = p0; qd[1] = p1;
              u32x2* g = (u32x2*)(blk + DN_QD + tt * 264 + 32 * cg);
              u32x2 o; o.x = cvtpk_c(a[0] * egc, a[1] * egc); o.y = cvtpk_c(a[2] * egc, a[3] * egc); g[0] = o;
              o.x = cvtpk_c(a[4] * egc, a[5] * egc); o.y = cvtpk_c(a[6] * egc, a[7] * egc); g[1] = o;
              o.x = cvtpk_c(a[8] * egc, a[9] * egc); o.y = cvtpk_c(a[10] * egc, a[11] * egc); g[2] = o;
              o.x = cvtpk_c(a[12] * egc, a[13] * egc); o.y = cvtpk_c(a[14] * egc, a[15] * egc); g[3] = o;
          } else {
              if (seg == 1) { u32x4 p0, p1; p0.x = cvtpk_c(a[0], a[1]); p0.y = cvtpk_c(a[2], a[3]); p0.z = cvtpk_c(a[4], a[5]); p0.w = cvtpk_c(a[6], a[7]);
                  p1.x = cvtpk_c(a[8], a[9]); p1.y = cvtpk_c(a[10], a[11]); p1.z = cvtpk_c(a[12], a[13]); p1.w = cvtpk_c(a[14], a[15]);
                  LAS u32x4* kd = (LAS u32x4*)(L + CL_KS + tt * 272 + 32 * cg); kd[0] = p0; kd[1] = p1; }
              LAS bf16* tp = (LAS bf16*)(L + (seg == 1 ? CL_KT : CL_VT)) + (16 * cg) * 72 + ((tt + 8 * cg) & 63);
#pragma unroll
              for (int e = 0; e < 16; ++e) tp[e * 72] = (bf16)(cvtpk_c(a[e], 0.f) & 0xffffu);
          }
      } }
    __syncthreads();
    { const int mat = wave >> 2, ti = (wave >> 1) & 1, tj = wave & 1, r = lane & 31;
      f32x16 acc;
#pragma unroll
      for (int i = 0; i < 16; ++i) acc[i] = 0.f;
      if (!(ti == 0 && tj == 1)) {
          const LAS unsigned char* ap = L + (mat == 0 ? CL_KS : CL_QS) + (32 * ti + r) * 272 + 16 * hh;
          const LAS unsigned char* bp = L + CL_KS + (32 * tj + r) * 272 + 16 * hh;
#pragma unroll
          for (int s = 0; s < 8; ++s) acc = __builtin_amdgcn_mfma_f32_32x32x16_bf16(*(const LAS bf16x8*)(ap + 32 * s), *(const LAS bf16x8*)(bp + 32 * s), acc, 0, 0, 0);
      }
      const int j = 32 * tj + r; const float gcj = gcs[j];
#pragma unroll
      for (int reg = 0; reg < 16; ++reg) { const int i = 32 * ti + crow16(reg, hh);
          const float e = (i >= j) ? __expf(gcs[i] - gcj) : 0.f;
          if (mat == 0) { const float val = (i > j) ? betas[i] * acc[reg] * e : 0.f;
              ((LAS float*)(L + CL_AS))[i * 68 + j] = val;
              if (ti == 1 && tj == 0) ((LAS bf16*)(L + CL_A10))[(i - 32) * 40 + j] = (bf16)(cvtpk_c(val, 0.f) & 0xffffu); }
          else ((LAS bf16*)(L + CL_QK))[i * 68 + j] = (bf16)(cvtpk_c(acc[reg] * e, 0.f) & 0xffffu); }
    }
    __syncthreads();
    if (wave == 0) {
        const int half = hh, c = lane & 31, cf = 32 * half + c;
        const LAS float* Ab = (const LAS float*)(L + CL_AS) + (32 * half) * 68 + 32 * half;
        float t[32];
        f32x4 cur[8], nxt[8];
#pragma unroll
        for (int q = 0; q < 8; ++q) { cur[q] = (f32x4){0.f, 0.f, 0.f, 0.f}; nxt[q] = cur[q]; }
#pragma unroll
        for (int i = 0; i < 32; ++i) {
            if (i + 1 < 32) {
#pragma unroll
                for (int j4 = 0; j4 < (i + 4) / 4; ++j4) nxt[j4] = *(const LAS f32x4*)(Ab + (i + 1) * 68 + 4 * j4); }
            float s0 = (i == c) ? 1.f : 0.f, s1 = 0.f;
#pragma unroll
            for (int j4 = 0; j4 < (i + 3) / 4; ++j4) {
#pragma unroll
                for (int e = 0; e < 4; ++e) { const int jj = 4 * j4 + e; if (jj < i) { if (jj & 1) s1 -= cur[j4][e] * t[jj]; else s0 -= cur[j4][e] * t[jj]; } } }
            t[i] = s0 + s1;
#pragma unroll
            for (int q = 0; q < 8; ++q) cur[q] = nxt[q];
            asm volatile("" : "+v"(t[i]) :: "memory");
        }
        const float csu = betas[cf], csw = csu * __expf(gcs[cf]);
        LAS bf16* Tw = (LAS bf16*)(L + CL_TW); LAS bf16* Tu = (LAS bf16*)(L + CL_TU); LAS bf16* Tb = (LAS bf16*)(L + CL_TB);
#pragma unroll
        for (int i = 0; i < 32; ++i) { const int rf = 32 * half + i;
            Tw[rf * 72 + cf] = (bf16)(cvtpk_c(t[i] * csw, 0.f) & 0xffffu); Tu[rf * 72 + cf] = (bf16)(cvtpk_c(t[i] * csu, 0.f) & 0xffffu);
            if (half == 1) { Tb[rf * 72 + cf] = (bf16)(cvtpk_c(t[i], 0.f) & 0xffffu); Tw[i * 72 + cf] = 0; Tu[i * 72 + cf] = 0; } }
        if (half == 0) { LAS u32x4* tt4 = (LAS u32x4*)(L + CL_TT + c * 80);
#pragma unroll
            for (int q = 0; q < 4; ++q) { u32x4 w; w.x = cvtpk_c(t[8 * q], t[8 * q + 1]); w.y = cvtpk_c(t[8 * q + 2], t[8 * q + 3]); w.z = cvtpk_c(t[8 * q + 4], t[8 * q + 5]); w.w = cvtpk_c(t[8 * q + 6], t[8 * q + 7]); tt4[q] = w; } }
        f32x16 xacc, tacc;
#pragma unroll
        for (int i = 0; i < 16; ++i) { xacc[i] = 0.f; tacc[i] = 0.f; }
#pragma unroll
        for (int s = 0; s < 2; ++s) xacc = __builtin_amdgcn_mfma_f32_32x32x16_bf16(*(const LAS bf16x8*)(L + CL_A10 + c * 80 + 32 * s + 16 * hh), *(const LAS bf16x8*)(L + CL_TT + c * 80 + 32 * s + 16 * hh), xacc, 0, 0, 0);
#pragma unroll
        for (int s = 0; s < 2; ++s) tacc = __builtin_amdgcn_mfma_f32_32x32x16_bf16(ld_perm(L + CL_TB + (32 + c) * 144 + (32 + 16 * s + 4 * hh) * 2), pack_step(xacc, s), tacc, 0, 0, 0);
        const float c0u = betas[c], c0w = c0u * __expf(gcs[c]);
#pragma unroll
        for (int reg = 0; reg < 16; ++reg) { const int i = 32 + crow16(reg, hh); const float v = -tacc[reg];
            Tw[i * 72 + c] = (bf16)(cvtpk_c(v * c0w, 0.f) & 0xffffu); Tu[i * 72 + c] = (bf16)(cvtpk_c(v * c0u, 0.f) & 0xffffu); }
    } else {
        const int t7 = tid - 64;
        for (int e = t7; e < 8704 / 8; e += 448) *(u32x2*)(blk + DN_QK + 8 * e) = *(const LAS u32x2*)(L + CL_QK + 8 * e);
        for (int e = t7; e < 128 * 8; e += 448) { const int dk = e >> 3, c8 = e & 7;
            const u32x4 kk = *(const LAS u32x4*)(L + CL_KT + dk * 144 + 16 * ((c8 + (dk >> 4)) & 7));
            const LAS float* gp = gcs + 8 * c8; float kd[8];
#pragma unroll
            for (int q = 0; q < 8; ++q) kd[q] = __expf(gc_last - gp[q]);
            u32x2 o0, o1; o0.x = cvtpk_c(bf_lo(kk.x) * kd[0], bf_hi(kk.x) * kd[1]); o0.y = cvtpk_c(bf_lo(kk.y) * kd[2], bf_hi(kk.y) * kd[3]);
            o1.x = cvtpk_c(bf_lo(kk.z) * kd[4], bf_hi(kk.z) * kd[5]); o1.y = cvtpk_c(bf_lo(kk.w) * kd[6], bf_hi(kk.w) * kd[7]);
            u32x2* g = (u32x2*)(blk + DN_KDT + dk * 136 + 16 * c8); g[0] = o0; g[1] = o1; }
        if (t7 == 0) GL[unit] = __expf(gc_last);
    }
    __syncthreads();
    { const int r = lane & 31;
      { const int dkt = wave >> 1, it = wave & 1, dk = 32 * dkt + r;
        f32x16 acc;
#pragma unroll
        for (int i = 0; i < 16; ++i) acc[i] = 0.f;
#pragma unroll
        for (int s = 0; s < 4; ++s) acc = __builtin_amdgcn_mfma_f32_32x32x16_bf16(*(const LAS bf16x8*)(L + CL_KT + dk * 144 + 16 * ((2 * s + hh + (dk >> 4)) & 7)),
                                                                                  *(const LAS bf16x8*)(L + CL_TW + (32 * it + r) * 144 + 32 * s + 16 * hh), acc, 0, 0, 0);
        LAS unsigned char* wp = L + CL_KS + (32 * it + r) * 264 + (32 * dkt + 4 * hh) * 2;
#pragma unroll
        for (int g = 0; g < 4; ++g) { u32x2 w; w.x = cvtpk_c(-acc[4 * g], -acc[4 * g + 1]); w.y = cvtpk_c(-acc[4 * g + 2], -acc[4 * g + 3]); *(LAS u32x2*)(wp + 16 * g) = w; } }
      { const int it = wave >> 2, dvt = wave & 3, dv = 32 * dvt + r;
        f32x16 acc;
#pragma unroll
        for (int i = 0; i < 16; ++i) acc[i] = 0.f;
#pragma unroll
        for (int s = 0; s < 4; ++s) acc = __builtin_amdgcn_mfma_f32_32x32x16_bf16(*(const LAS bf16x8*)(L + CL_TU + (32 * it + r) * 144 + 32 * s + 16 * hh),
                                                                                  *(const LAS bf16x8*)(L + CL_VT + dv * 144 + 16 * ((2 * s + hh + (dv >> 4)) & 7)), acc, 0, 0, 0);
        float* up = Ubuf + (size_t)unit * 8192 + (dvt * 2 + it) * 1024 + lane;
#pragma unroll
        for (int reg = 0; reg < 16; ++reg) up[64 * reg] = acc[reg]; } }
    __syncthreads();
    for (int e = tid; e < 16896 / 16; e += 512) *(u32x4*)(blk + DN_NW + 16 * e) = *(const LAS u32x4*)(L + CL_KS + 16 * e);
    __syncthreads();
}

__device__ __forceinline__ void dn_gate_rows(int bh, const float* ORAW, const bf16* PROJ, const float* dn_norm, bf16* CONCAT, int lane, int wave) {
    const int h = bh & 15, b = bh >> 4, sub = lane >> 4, c = 8 * (lane & 15);
    const f32x4 g0 = *(const f32x4*)(dn_norm + c), g1 = *(const f32x4*)(dn_norm + c + 4);
    for (int t0 = wave * 256; t0 < wave * 256 + 256; t0 += 16) {
        f32x4 o0[4], o1[4]; u32x4 zz[4];
#pragma unroll
        for (int u = 0; u < 4; ++u) { const size_t m = (size_t)b * SEQ + t0 + 4 * u + sub; const float* op = ORAW + m * 2048 + h * HD + c;
            o0[u] = *(const f32x4*)op; o1[u] = *(const f32x4*)(op + 4); zz[u] = *(const u32x4*)(PROJ + m * LDP + PJ_DZ + h * HD + c); }
#pragma unroll
        for (int u = 0; u < 4; ++u) { const size_t m = (size_t)b * SEQ + t0 + 4 * u + sub;
            float ss = (o0[u][0] * o0[u][0] + o0[u][1] * o0[u][1]) + (o0[u][2] * o0[u][2] + o0[u][3] * o0[u][3]) + (o1[u][0] * o1[u][0] + o1[u][1] * o1[u][1]) + (o1[u][2] * o1[u][2] + o1[u][3] * o1[u][3]);
            ss += __shfl_xor(ss, 1); ss += __shfl_xor(ss, 2); ss += __shfl_xor(ss, 4); ss += __shfl_xor(ss, 8);
            const float r = rsqrtf(ss * (1.0f / HD) + EPS);
            u32x4 w;
            w.x = pk2(o0[u][0] * r * g0[0] * pg8::silu_f(bf_lo(zz[u].x)), o0[u][1] * r * g0[1] * pg8::silu_f(bf_hi(zz[u].x)));
            w.y = pk2(o0[u][2] * r * g0[2] * pg8::silu_f(bf_lo(zz[u].y)), o0[u][3] * r * g0[3] * pg8::silu_f(bf_hi(zz[u].y)));
            w.z = pk2(o1[u][0] * r * g1[0] * pg8::silu_f(bf_lo(zz[u].z)), o1[u][1] * r * g1[1] * pg8::silu_f(bf_hi(zz[u].z)));
            w.w = pk2(o1[u][2] * r * g1[2] * pg8::silu_f(bf_lo(zz[u].w)), o1[u][3] * r * g1[3] * pg8::silu_f(bf_hi(zz[u].w)));
            *(u32x4*)(CONCAT + m * LDD + 2048 + h * HD + c) = w; }
    }
}
__device__ __forceinline__ void dn_scan(int bh, const unsigned char* blocks, const float* Ubuf, const float* GL, float* ORAW, LAS unsigned char* L, int tid, int lane, int wave) {
    const int h = bh & 15, b = bh >> 4;
    if (wave >= 4) {
        const unsigned char* src = blocks + (size_t)(bh * 32) * DN_BLK;
        { u32x4 v[15];
#pragma unroll
          for (int j = 0; j < 15; ++j) { const int e = tid - 256 + 256 * j; if (e < DN_BLK / 16) v[j] = *(const u32x4*)(src + 16 * e); }
#pragma unroll
          for (int j = 0; j < 15; ++j) { const int e = tid - 256 + 256 * j; if (e < DN_BLK / 16) *(LAS u32x4*)(L + 16 * e) = v[j]; } }
        for (int n = 0; n < 32; ++n) {
            __syncthreads();
            if (n + 1 < 32) { const unsigned char* sp = src + (size_t)(n + 1) * DN_BLK; LAS unsigned char* dst = L + ((n + 1) & 1) * DN_BLK;
                u32x4 v[15];
#pragma unroll
                for (int j = 0; j < 15; ++j) { const int e = tid - 256 + 256 * j; if (e < DN_BLK / 16) v[j] = *(const u32x4*)(sp + 16 * e); }
#pragma unroll
                for (int j = 0; j < 15; ++j) { const int e = tid - 256 + 256 * j; if (e < DN_BLK / 16) *(LAS u32x4*)(dst + 16 * e) = v[j]; } }
        }
        __syncthreads();
        return;
    }
    int r = lane & 31, hh = lane >> 5;
    f32x16 Sacc[4];
#pragma unroll
    for (int t = 0; t < 4; ++t)
#pragma unroll
        for (int i = 0; i < 16; ++i) Sacc[t][i] = 0.f;
    const float* up = Ubuf + (size_t)(bh * 32) * 8192 + (wave * 2) * 1024 + lane;
    float* op = ORAW + (size_t)(b * SEQ) * 2048 + h * HD + 32 * wave + r;
    for (int n = 0; n < 32; ++n) {
        f32x16 x0, x1;
#pragma unroll
        for (int reg = 0; reg < 16; ++reg) { x0[reg] = up[64 * reg]; x1[reg] = up[1024 + 64 * reg]; }
        const float gl = GL[bh * 32 + n];
        __syncthreads();
        const LAS unsigned char* B = L + (n & 1) * DN_BLK;
#pragma unroll
        for (int t = 0; t < 4; ++t)
#pragma unroll
            for (int s = 0; s < 2; ++s) { const bf16x8 sb = pack_step(Sacc[t], s); const int co = (32 * t + 16 * s + 4 * hh) * 2;
                x0 = __builtin_amdgcn_mfma_f32_32x32x16_bf16(ld_perm(B + DN_NW + r * 264 + co), sb, x0, 0, 0, 0);
                x1 = __builtin_amdgcn_mfma_f32_32x32x16_bf16(ld_perm(B + DN_NW + (32 + r) * 264 + co), sb, x1, 0, 0, 0); }
        const bf16x8 v00 = pack_step(x0, 0), v01 = pack_step(x0, 1), v10 = pack_step(x1, 0), v11 = pack_step(x1, 1);
        f32x16 o0, o1;
#pragma unroll
        for (int i = 0; i < 16; ++i) { o0[i] = 0.f; o1[i] = 0.f; }
#pragma unroll
        for (int t = 0; t < 4; ++t)
#pragma unroll
            for (int s = 0; s < 2; ++s) { const bf16x8 sb = pack_step(Sacc[t], s); const int co = (32 * t + 16 * s + 4 * hh) * 2;
                o0 = __builtin_amdgcn_mfma_f32_32x32x16_bf16(ld_perm(B + DN_QD + r * 264 + co), sb, o0, 0, 0, 0);
                o1 = __builtin_amdgcn_mfma_f32_32x32x16_bf16(ld_perm(B + DN_QD + (32 + r) * 264 + co), sb, o1, 0, 0, 0); }
        o0 = __builtin_amdgcn_mfma_f32_32x32x16_bf16(ld_perm(B + DN_QK + r * 136 + (4 * hh) * 2), v00, o0, 0, 0, 0);
        o0 = __builtin_amdgcn_mfma_f32_32x32x16_bf16(ld_perm(B + DN_QK + r * 136 + (16 + 4 * hh) * 2), v01, o0, 0, 0, 0);
        o1 = __builtin_amdgcn_mfma_f32_32x32x16_bf16(ld_perm(B + DN_QK + (32 + r) * 136 + (4 * hh) * 2), v00, o1, 0, 0, 0);
        o1 = __builtin_amdgcn_mfma_f32_32x32x16_bf16(ld_perm(B + DN_QK + (32 + r) * 136 + (16 + 4 * hh) * 2), v01, o1, 0, 0, 0);
        o1 = __builtin_amdgcn_mfma_f32_32x32x16_bf16(ld_perm(B + DN_QK + (32 + r) * 136 + (32 + 4 * hh) * 2), v10, o1, 0, 0, 0);
        o1 = __builtin_amdgcn_mfma_f32_32x32x16_bf16(ld_perm(B + DN_QK + (32 + r) * 136 + (48 + 4 * hh) * 2), v11, o1, 0, 0, 0);
#pragma unroll
        for (int reg = 0; reg < 16; ++reg) { const int i = crow16(reg, hh); op[(size_t)i * 2048] = o0[reg]; op[(size_t)(32 + i) * 2048] = o1[reg]; }
#pragma unroll
        for (int t = 0; t < 4; ++t) {
#pragma unroll
            for (int i = 0; i < 16; ++i) Sacc[t][i] *= gl;
            const LAS unsigned char* kp = B + DN_KDT + (32 * t + r) * 136 + (4 * hh) * 2;
            Sacc[t] = __builtin_amdgcn_mfma_f32_32x32x16_bf16(ld_perm(kp), v00, Sacc[t], 0, 0, 0);
            Sacc[t] = __builtin_amdgcn_mfma_f32_32x32x16_bf16(ld_perm(kp + 32), v01, Sacc[t], 0, 0, 0);
            Sacc[t] = __builtin_amdgcn_mfma_f32_32x32x16_bf16(ld_perm(kp + 64), v10, Sacc[t], 0, 0, 0);
            Sacc[t] = __builtin_amdgcn_mfma_f32_32x32x16_bf16(ld_perm(kp + 96), v11, Sacc[t], 0, 0, 0); }
        up += 8192; op += (size_t)64 * 2048;
    }
    __syncthreads();
}

struct Args { const float* in[17]; float* out; unsigned char* ws; int ph_lo, ph_hi; };
constexpr int NPH = 11;

__global__ void __launch_bounds__(NWAVES * 64, 2) fwd(Args args) {
    extern __shared__ __attribute__((aligned(16))) unsigned char lds[];
    LAS unsigned char* L = (LAS unsigned char*)lds;
    volatile LAS unsigned* MISC = (volatile LAS unsigned*)(L + MISC_OFF);
    const int wave = __builtin_amdgcn_readfirstlane((int)threadIdx.x >> 6);
    int lane = fresh_lane(), tid = wave * 64 + lane;
#define REFRESH_IDS() do { lane = fresh_lane(); tid = wave * 64 + lane; } while (0)
    const int G = gridDim.x; const int bx = blockIdx.x; const int vcu = (G % 8 == 0) ? (bx % 8) * (G / 8) + bx / 8 : bx;
    const int gw = vcu * NWAVES + wave, NGW = G * NWAVES;
    unsigned char* ws = args.ws;
    unsigned* ctl = (unsigned*)(ws + WS_CTL);
    const float* x = args.in[0];
    float* out = args.out;
    unsigned long long* ssq = (unsigned long long*)(ws + WS_SSQ);
    float* BETA = (float*)(ws + WS_BETA); float* GLOG = (float*)(ws + WS_G);
    bf16* Wgu1 = (bf16*)(ws + WS_WGU1); bf16* Wd1 = (bf16*)(ws + WS_WD1); bf16* Win = (bf16*)(ws + WS_WIN); bf16* Wout = (bf16*)(ws + WS_WOUT);
    bf16* Wgu2 = (bf16*)(ws + WS_WGU2); bf16* Wd2 = (bf16*)(ws + WS_WD2);
    bf16* XB = (bf16*)(ws + WS_XB); bf16* ACT = (bf16*)(ws + WS_ACT); bf16* PROJ = (bf16*)(ws + WS_PROJ); bf16* CONCAT = (bf16*)(ws + WS_CONCAT);
    unsigned char* DNB = ws + WS_ACT; float* UBUF = (float*)(ws + WS_QN); float* GLAST = (float*)(ws + WS_GL); float* ORAW = (float*)(ws + WS_ORAW);

    for (int u = tid; u < (LDS_BYTES - LDSCTL_OFF) / 4; u += NWAVES * 64) ((LAS unsigned*)(L + LDSCTL_OFF))[u] = 0u;
    __syncthreads();
    XcdBarrier bar; bar.bar = ctl + CW_BAR; bar.x = 0; bar.st = nullptr; bar.w = wave;
#if ONE_LAUNCH
    bar = xcd_barrier_post(ctl + CW_BAR, MISC + 8); bar.w = wave;
#define GRID_BAR() xcd_barrier(bar)
#else
#define GRID_BAR() do { } while (0)
#endif
    const int lo = args.ph_lo, hi = args.ph_hi;
#define IN(k) (lo <= (k) && (k) < hi)
#define BOTH(k) (IN(k) && IN((k) + 1))

    constexpr int T_GU = (D / 64) * (FF / 64), T_DN = (FF / 64) * (D / 64), NT_IN = (NPROJ + 63) / 64, T_IN = (D / 64) * NT_IN, T_OUT = (D / 64) * (D / 64);
    constexpr int NITEMS = 4 * T_GU + 2 * T_DN + T_IN + T_OUT, NI0 = 2 * T_GU + T_DN + T_IN, NCB = (NITEMS - NI0) / 64;
    static_assert((NITEMS - NI0) % 64 == 0, "deferred conversion tiles come in whole batches");
#define P0T_SET(x, pw_, pg_, pt_, pk_, pn_, pkk_, pnn_, pld_, pb_, po_) do { x##W = (pw_); x##G = (pg_); x##T = (pt_); x##K = (pk_); x##N = (pn_); x##k0 = (pkk_); x##n0 = (pnn_); x##ld = (pld_); x##blk = (pb_); x##off = (po_); } while (0)
#define P0T_RESOLVE(x, item) do { int r_ = (item); \
            if (r_ < 2 * T_GU) { const int wh_ = r_ / T_GU; r_ -= wh_ * T_GU; P0T_SET(x, args.in[2 + wh_], args.in[1], Wgu1, D, FF, 64 * (r_ / (FF / 64)), 64 * (r_ % (FF / 64)), LDD, 256, 128 * wh_); break; } r_ -= 2 * T_GU; \
            if (r_ < T_DN) { P0T_SET(x, args.in[4], nullptr, Wd1, FF, D, 64 * (r_ / (D / 64)), 64 * (r_ % (D / 64)), LDF, 128, 0); break; } r_ -= T_DN; \
            if (r_ < T_IN) { P0T_SET(x, args.in[6], args.in[5], Win, D, NPROJ, 64 * (r_ / NT_IN), 64 * (r_ % NT_IN), LDD, 128, 0); break; } r_ -= T_IN; \
            if (r_ < T_OUT) { P0T_SET(x, args.in[11], nullptr, Wout, D, D, 64 * (r_ / (D / 64)), 64 * (r_ % (D / 64)), LDD, 128, 0); break; } r_ -= T_OUT; \
            if (r_ < 2 * T_GU) { const int wh_ = r_ / T_GU; r_ -= wh_ * T_GU; P0T_SET(x, args.in[13 + wh_], args.in[12], Wgu2, D, FF, 64 * (r_ / (FF / 64)), 64 * (r_ % (FF / 64)), LDD, 256, 128 * wh_); break; } r_ -= 2 * T_GU; \
            P0T_SET(x, args.in[15], nullptr, Wd2, FF, D, 64 * (r_ / (D / 64)), 64 * (r_ % (D / 64)), LDF, 128, 0); } while (0)
#define P0_RUN(first, end, stride) do { if ((first) < (end)) { \
            f32x4 va[16], vb[16]; P0T_DECL(a); P0T_DECL(b); \
            P0T_RESOLVE(a, (first)); p0_load(aW, aN, ak0, an0, lane, va); \
            for (int it = (first); it < (end); it += 2 * (stride)) {             \
                const bool hb = it + (stride) < (end); if (hb) { P0T_RESOLVE(b, it + (stride)); p0_load(bW, bN, bk0, bn0, lane, vb); } \
                p0_finish(aT, aG, aN, ak0, an0, ald, ablk, aoff, lane, va, scr); \
                if (!hb) break; \
                const bool ha = it + 2 * (stride) < (end); if (ha) { P0T_RESOLVE(a, it + 2 * (stride)); p0_load(aW, aN, ak0, an0, lane, va); } \
                p0_finish(bT, bG, bN, bk0, bn0, bld, bblk, boff, lane, vb, scr); \
            } } } while (0)
    if (IN(0)) {
        REFRESH_IDS();
        LAS float* scr = (LAS float*)(L + wave * (64 * 65 * 4));
        P0_RUN(gw, NI0, NGW);
        for (int row = gw; row < M; row += NGW) {
            const f32x4* xr = (const f32x4*)(x + (size_t)row * D) + lane; float s = 0.f;
#pragma unroll
            for (int j = 0; j < 16; ++j) { const f32x4 v = xr[64 * j]; s += (v[0] * v[0] + v[1] * v[1]) + (v[2] * v[2] + v[3] * v[3]);
                u32x2 o; o.x = pk2(v[0], v[1]); o.y = pk2(v[2], v[3]); *(u32x2*)(XB + (size_t)row * LDD + 4 * lane + 256 * j) = o; }
            s = wave_sum(s);
            if (lane == 0) ssq[row] = (unsigned long long)(s * FIXS);
        }
        if (BOTH(0)) GRID_BAR();
    }

    if (IN(1)) {
        REFRESH_IDS();
        pg8::Gemm g{XB, Wgu1, M, 2 * FF, D, LDD, LDD}; pg8::StaticOrder S; S.init(M, 2 * FF, G, bx);
        pg8::EpiGateUp E{ACT, ssq};
        pg8::gemm_phase<pg8::EpiGateUp, pg8::StaticOrder, true, true>(L, g, S, E, wave);
        if (BOTH(1)) GRID_BAR();
    }
    if (IN(2)) {
        REFRESH_IDS();
#if DEFER_AT == 2
        { LAS float* scr = (LAS float*)(L + wave * (64 * 65 * 4)); P0_RUN(NI0 + gw, NITEMS, NGW); __syncthreads(); REFRESH_IDS(); }
#endif
        pg8::Gemm g{ACT, Wd1, M, D, FF, LDF, LDF}; pg8::StaticOrder S; S.init(M, D, G, bx);
        pg8::EpiResid<true> E{x, out, XB, ssq + M, 0.5f};
        pg8::gemm_phase<pg8::EpiResid<true>, pg8::StaticOrder, true, true>(L, g, S, E, wave);
        if (BOTH(2)) GRID_BAR();
    }
    if (IN(3)) {
        REFRESH_IDS();
        {
            for (int rt = bx; rt < M / 32; rt += G) {
                const int r = lane & 31, hh = lane >> 5;
                const bf16* ap = XB + (size_t)(32 * rt + r) * LDD + wave * 512 + 8 * hh;
                const bf16* bp = Win + (size_t)(NPROJ_MAIN + r) * LDD + wave * 512 + 8 * hh;
                f32x16 acc; for (int i = 0; i < 16; ++i) acc[i] = 0.f;
#pragma unroll 8
                for (int kk = 0; kk < 32; ++kk) { const bf16x8 a = *(const bf16x8*)(ap + 16 * kk), b = *(const bf16x8*)(bp + 16 * kk);
                    acc = __builtin_amdgcn_mfma_f32_32x32x16_bf16(a, b, acc, 0, 0, 0); }
                LAS float* red = (LAS float*)L;
                __syncthreads();
#pragma unroll
                for (int i = 0; i < 16; ++i) red[(wave * 64 + lane) * 16 + i] = acc[i];
                __syncthreads();
#pragma unroll
                for (int q = 0; q < 2; ++q) { const int idx = tid + 512 * q, ln = idx >> 4, reg = idx & 15; float s = 0.f;
#pragma unroll
                    for (int w = 0; w < 8; ++w) s += red[(w * 64 + ln) * 16 + reg];
                    const int col = ln & 31, rowi = (reg & 3) + 8 * (reg >> 2) + 4 * (ln >> 5), row = 32 * rt + rowi;
                    const float val = s * pg8::rstd_of(ssq + M, row);
                    if (col < 16) BETA[row * 16 + col] = 1.0f / (1.0f + __expf(-val));
                    else { const int h = col - 16; const float z = val + args.in[9][h]; const float sp = fmaxf(z, 0.f) + log1pf(__expf(-fabsf(z)));
                        GLOG[row * 16 + h] = -__expf(args.in[8][h]) * sp; } }
            }
            __syncthreads();
        }
        pg8::Gemm g{XB, Win, M, NPROJ_MAIN, D, LDD, LDD}; pg8::StaticOrder S; S.init(M, NPROJ_MAIN, G, bx);
        pg8::EpiProj E{PROJ, ssq + M};
        pg8::gemm_phase<pg8::EpiProj, pg8::StaticOrder, true, true>(L, g, S, E, wave);
        if (BOTH(3)) GRID_BAR();
    }
    if (IN(4)) {
        REFRESH_IDS();
        for (int unit = vcu; unit < 2048; unit += G) dn_chunk_local(unit, PROJ, args.in[7], GLOG, BETA, DNB, UBUF, GLAST, L, tid, lane, wave);
        if (BOTH(4)) GRID_BAR();
    }
    if (IN(5)) {
        REFRESH_IDS();
        if (vcu < 64) { dn_scan(vcu, DNB, UBUF, GLAST, ORAW, L, tid, lane, wave);
            REFRESH_IDS(); dn_gate_rows(vcu, ORAW, PROJ, args.in[10], CONCAT, lane, wave); REFRESH_IDS(); }
        { LAS float* scr = (LAS float*)(L + wave * (64 * 65 * 4));
          for (;;) {
            __syncthreads();
            if (tid == 0) MISC[16] = __hip_atomic_fetch_add(ctl + CW_AQ, 1u, __ATOMIC_RELAXED, __HIP_MEMORY_SCOPE_AGENT);
            __syncthreads();
            const unsigned q = MISC[16]; if (q >= 512u + (DEFER_AT == 5 ? (unsigned)NCB : 0u)) break;
            REFRESH_IDS();
#if QORDER == 0
            const bool conv = DEFER_AT == 5 ? (q < 1024u ? (q & 1u) != 0u : true) : false; const int idx = DEFER_AT == 5 ? (q < 1024u ? (int)(q >> 1) : (int)(q - 512u)) : (int)q;
#elif QORDER == 1
            const bool conv = q >= 512u; const int idx = conv ? (int)(q - 512u) : (int)q;
#else
            const bool conv = q < (unsigned)NCB; const int idx = conv ? (int)q : (int)(q - (unsigned)NCB);
#endif
            if (!conv) attn_wg(PROJ, CONCAT, idx, L, tid, lane, wave);
            else {
                const int first = NI0 + idx * 64 + wave;
                f32x4 va[16], vb[16]; P0T_DECL(a); P0T_DECL(b);
#define CV_LA(k) do { P0T_RESOLVE(a, first + 8 * (k)); p0_load(aW, aN, ak0, an0, lane, va); } while (0)
#define CV_LB(k) do { P0T_RESOLVE(b, first + 8 * (k)); p0_load(bW, bN, bk0, bn0, lane, vb); } while (0)
#define CV_FA() p0_finish(aT, aG, aN, ak0, an0, ald, ablk, aoff, lane, va, scr)
#define CV_FB() p0_finish(bT, bG, bN, bk0, bn0, bld, bblk, boff, lane, vb, scr)
                CV_LA(0); CV_LB(1); CV_FA(); CV_LA(2); CV_FB(); CV_LB(3); CV_FA(); CV_LA(4); CV_FB(); CV_LB(5); CV_FA(); CV_LA(6); CV_FB(); CV_LB(7); CV_FA(); CV_FB();
#undef CV_LA
#undef CV_LB
#undef CV_FA
#undef CV_FB
            }
          } }
        if (BOTH(5)) GRID_BAR();
    }
    if (IN(7)) {
        REFRESH_IDS();
        pg8::Gemm g{CONCAT, Wout, M, D, D, LDD, LDD}; pg8::StaticOrder S; S.init(M, D, G, bx);
        pg8::EpiResid<true> E{out, out, XB, ssq + 2 * M, 1.0f};
        pg8::gemm_phase<pg8::EpiResid<true>, pg8::StaticOrder, true, true>(L, g, S, E, wave);
        if (BOTH(7)) GRID_BAR();
    }
    if (IN(8)) {
        REFRESH_IDS();
        pg8::Gemm g{XB, Wgu2, M, 2 * FF, D, LDD, LDD}; pg8::StaticOrder S; S.init(M, 2 * FF, G, bx);
        pg8::EpiGateUp E{ACT, ssq + 2 * M};
        pg8::gemm_phase<pg8::EpiGateUp, pg8::StaticOrder, true, true>(L, g, S, E, wave);
        if (BOTH(8)) GRID_BAR();
    }
    if (IN(9)) {
        REFRESH_IDS();
        pg8::Gemm g{ACT, Wd2, M, D, FF, LDF, LDF}; pg8::StaticOrder S; S.init(M, D, G, bx);
        pg8::EpiResid<true, false> E{out, out, XB, ssq + 3 * M, 0.5f};
        pg8::gemm_phase<pg8::EpiResid<true, false>, pg8::StaticOrder, true, true>(L, g, S, E, wave);
        if (BOTH(9)) GRID_BAR();
    }
    if (IN(10)) {
        REFRESH_IDS();
        const float* fn = args.in[16];
        for (int row = gw; row < M; row += NGW) {
            const float rs = pg8::rstd_of(ssq + 3 * M, row);
            const u32x4* hr = (const u32x4*)(XB + (size_t)row * LDD) + lane; f32x4* orow = (f32x4*)(out + (size_t)row * D) + 2 * lane; const f32x4* gp = (const f32x4*)fn + 2 * lane;
#pragma unroll
            for (int j = 0; j < 8; ++j) { const u32x4 hv = hr[64 * j]; const f32x4 g0 = gp[128 * j], g1 = gp[128 * j + 1];
                f32x4 o0, o1; o0[0] = bf_lo(hv.x) * rs * g0[0]; o0[1] = bf_hi(hv.x) * rs * g0[1]; o0[2] = bf_lo(hv.y) * rs * g0[2]; o0[3] = bf_hi(hv.y) * rs * g0[3];
                o1[0] = bf_lo(hv.z) * rs * g1[0]; o1[1] = bf_hi(hv.z) * rs * g1[1]; o1[2] = bf_lo(hv.w) * rs * g1[2]; o1[3] = bf_hi(hv.w) * rs * g1[3];
                orow[128 * j] = o0; orow[128 * j + 1] = o1; }
        }
    }
#if PROBE_BARS
    for (int r = 0; r < PROBE_BARS; ++r) GRID_BAR();
#endif
#if PROBE_X
    if (IN(11)) {
        pg8::Gemm g{XB, Wgu1, M, 2 * FF, D, LDD, LDD}; pg8::StaticOrder S; S.init(M, 2 * FF, G, bx);
        pg8::EpiNull E{(float*)(ws + WS_ORAW)};
        pg8::gemm_phase<pg8::EpiNull, pg8::StaticOrder, true, true>(L, g, S, E, wave);
    }
    if (IN(12)) {
        pg8::Gemm g{XB, Wgu1, M, 2 * FF, D, LDD, LDD}; pg8::MaskOrder S; S.init(M, 2 * FF, G, bx); S.mm = 1; S.mn = 1;
        pg8::EpiNull E{(float*)(ws + WS_ORAW)};
        pg8::gemm_phase<pg8::EpiNull, pg8::MaskOrder, true, true>(L, g, S, E, wave);
    }
    if (IN(13)) {
        pg8::Gemm g{XB, Wgu1, M, 2 * FF, D, LDD, LDD}; pg8::StaticOrder S; S.init(M, 2 * FF, G, bx);
        pg8::EpiGateUp E{ACT, ssq};
        pg8::gemm_phase<pg8::EpiGateUp, pg8::StaticOrder, true, true>(L, g, S, E, wave);
    }
    if (IN(14)) {
        pg8::Gemm g{ACT, Wd1, M, D, FF, LDF, LDF}; pg8::StaticOrder S; S.init(M, D, G, bx);
        pg8::EpiNull E{(float*)(ws + WS_ORAW)};
        pg8::gemm_phase<pg8::EpiNull, pg8::StaticOrder, true, true>(L, g, S, E, wave);
    }
#endif
#undef P0_RUN
#undef P0T_RESOLVE
#undef P0T_SET
#undef IN
#undef BOTH
}

extern "C" void kernel_launch(void* const* d_in, const int* in_sizes, int n_in, void* d_out, int out_size, void* d_ws, size_t ws_size, hipStream_t stream) {
    static int grid = 0;
    if (grid == 0) {
        if (n_in != 17 || in_sizes[0] != M * D || out_size != M * D || ws_size < WS_END) { fprintf(stderr, "kernel_launch: unexpected shapes (n_in %d, in0 %d, out %d, ws %zu < %zu); nothing launched\n", n_in, n_in > 0 ? in_sizes[0] : -1, out_size, ws_size, (size_t)WS_END); grid = -1; return; }
        int dev = 0, cus = 0, per_cu = 0;
        if (hipGetDevice(&dev) != hipSuccess || hipDeviceGetAttribute(&cus, hipDeviceAttributeMultiprocessorCount, dev) != hipSuccess) { fprintf(stderr, "kernel_launch: device query failed\n"); grid = -1; return; }
        if (hipFuncSetAttribute((const void*)fwd, hipFuncAttributeMaxDynamicSharedMemorySize, LDS_BYTES) != hipSuccess) { fprintf(stderr, "kernel_launch: hipFuncSetAttribute failed\n"); grid = -1; return; }
        if (hipOccupancyMaxActiveBlocksPerMultiprocessor(&per_cu, (const void*)fwd, NWAVES * 64, LDS_BYTES) != hipSuccess || per_cu < 1) fprintf(stderr, "kernel_launch: note: occupancy query reports %d workgroups per CU\n", per_cu);
        (void)hipGetLastError();
        grid = cus;
    }
    if (grid < 0) return;
    if (hipMemsetAsync((char*)d_ws + WS_CTL, 0, CTL_ZERO_BYTES, stream) != hipSuccess) { fprintf(stderr, "kernel_launch: memset failed\n"); return; }
    Args a{};
    for (int i = 0; i < 17; ++i) a.in[i] = (const float*)d_in[i];
    a.out = (float*)d_out; a.ws = (unsigned char*)d_ws;
#if ONE_LAUNCH
    a.ph_lo = 0; a.ph_hi = NPH;
    hipLaunchKernelGGL(fwd, dim3(grid), dim3(NWAVES * 64), LDS_BYTES, stream, a);
#else
    for (int k = 0; k < NPH; ++k) { a.ph_lo = k; a.ph_hi = k + 1; for (int r = 0; r < (k == PROBE_REP ? 2 : 1); ++r) { if (r == 1 && PROBE_RESETQ) (void)hipMemsetAsync((char*)d_ws + CW_AQ * 4, 0, 4, stream); hipLaunchKernelGGL(fwd, dim3(grid), dim3(NWAVES * 64), LDS_BYTES, stream, a); } }
#endif
#if PROBE_X
    a.ph_lo = 10 + PROBE_X; a.ph_hi = 11 + PROBE_X; hipLaunchKernelGGL(fwd, dim3(grid), dim3(NWAVES * 64), LDS_BYTES, stream, a);
#endif
    const hipError_t le = hipPeekAtLastError();
    if (le != hipSuccess) fprintf(stderr, "kernel_launch: launch failed: %s\n", hipGetErrorName(le));
}
```

```cpp
#include <hip/hip_runtime.h>
#include <cstdio>
#include <cstdint>

#ifndef ONE_LAUNCH
#define ONE_LAUNCH 1
#endif
#ifndef PROBE_X
#define PROBE_X 0
#endif
#ifndef PROBE_RESETQ
#define PROBE_RESETQ 0
#endif
#ifndef DEFER_AT
#define DEFER_AT 5
#endif
#ifndef PROBE_BARS
#define PROBE_BARS 0
#endif
#ifndef QORDER
#define QORDER 1
#endif
#ifndef PROBE_REP
#define PROBE_REP -1
#endif

constexpr int M = 8192, SEQ = 2048, D = 4096, FF = 11008, NPROJ = 14368, NPROJ_MAIN = 14336, NH = 16, HD = 128;
constexpr int PJ_Q = 0, PJ_K = 2048, PJ_V = 4096, PJ_DQKV = 6144, PJ_DZ = 12288;
constexpr int LDD = D + 64, LDF = FF + 64, LDP = NPROJ_MAIN + 64;
constexpr float FIXS = 16777216.0f;
constexpr float EPS = 1e-6f;

__device__ __forceinline__ int fresh_lane() { int l; asm volatile("v_mbcnt_lo_u32_b32 %0, -1, 0\n\tv_mbcnt_hi_u32_b32 %0, -1, %0" : "=v"(l)); return l; }

namespace pg8 {
#define PG8_LAS __attribute__((address_space(3)))
typedef unsigned short bf16_t;
typedef short bf16x8 __attribute__((ext_vector_type(8)));
typedef float f32x4 __attribute__((ext_vector_type(4)));
typedef unsigned u32x4 __attribute__((ext_vector_type(4)));
constexpr int BM = 256, BK = 64, HALF = 128, HTB = HALF * BK * 2  , STAGE_BYTES = 8 * HTB, NXCD = 8, WGM = 8;

__host__ __device__ __forceinline__ int lds_byte(int r, int c) { const int st = (r >> 4) * 2 + (c >> 5), rr = r & 15, cc = c & 31, ob = rr * 64 + cc * 2; return st * 1024 + (ob ^ (((ob >> 9) & 1) << 5)); }
__host__ __device__ __forceinline__ void stage_rc(int b, int& R, int& C) { const int st = b / 1024, sb = b % 1024, swz = sb ^ (((sb >> 9) & 1) << 5); R = (st >> 1) * 16 + swz / 64; C = (st & 1) * 32 + (swz % 64) / 2; }
__host__ __device__ __forceinline__ int perm32(int rho) { const int n = rho >> 4, i = rho & 15; return 8 * (i >> 2) + 4 * n + (i & 3); }

struct Unit { int pm, pn; };
struct Gemm { const bf16_t* A; const bf16_t* Bt; int M, N, K, lda, ldb; };

struct StaticOrder {
    int nM, nN, nwg, G, c;
    __host__ __device__ void init(int M, int N, int G_, int c_) { nM = M / BM; nN = N / BM; nwg = nM * nN; G = G_; c = c_; }
    __host__ __device__ bool next(int i, Unit& u) const {
        const long L = (long)i * G + c; if (L >= nwg) return false;
        int wgid = (int)L; { const int q = nwg / NXCD, r = nwg % NXCD, xcd = wgid % NXCD, off = wgid / NXCD; wgid = (xcd < r ? xcd * (q + 1) : r * (q + 1) + (xcd - r) * q) + off; }
        const int nig = WGM * nN, gid = wgid / nig, fm = gid * WGM, gsz = (nM - fm) < WGM ? (nM - fm) : WGM;
        u.pm = fm + ((wgid % nig) % gsz); u.pn = (wgid % nig) / gsz; return true;
    }
    __device__ __forceinline__ void a_ready(const Unit&) const {}
    __device__ __forceinline__ void done(const Unit&) const {}
};

__device__ __forceinline__ unsigned cvt_pk_bf16(float lo, float hi) { unsigned r; asm volatile("v_cvt_pk_bf16_f32 %0, %1, %2" : "=v"(r) : "v"(lo), "v"(hi)); return r; }
typedef float f32x2 __attribute__((ext_vector_type(2)));

__device__ __forceinline__ float rstd_of(const unsigned long long* ssq, int row) {
    const unsigned long long q = ssq[row];
    const float s = (float)q * (1.0f / FIXS);
    return rsqrtf(s * (1.0f / (float)D) + EPS);
}
__device__ __forceinline__ float silu_f(float x) { return x * __builtin_amdgcn_rcpf(1.0f + __expf(-x)); }

struct EpiGateUp {
    static constexpr bool PERM = true, AFTER_DRAIN = false;
    bf16_t* O; const unsigned long long* ssq;
    __device__ __forceinline__ void operator()(const f32x4 (&acc)[2][2][4][2], const Unit& u, int wr, int wc, int fr, int fq) const {
        const int row0 = u.pm * BM + wr * 64 + fr, col0 = u.pn * HALF + wc * 32 + 8 * fq;
#pragma unroll
        for (int ai = 0; ai < 2; ++ai)
#pragma unroll
            for (int m = 0; m < 4; ++m) {
                const int row = row0 + ai * HALF + m * 16; const float rs = rstd_of(ssq, row);
                const f32x4 g0 = acc[ai][0][m][0] * rs, g1 = acc[ai][0][m][1] * rs, u0 = acc[ai][1][m][0] * rs, u1 = acc[ai][1][m][1] * rs;
                u32x4 w;
                w.x = cvt_pk_bf16(silu_f(g0[0]) * u0[0], silu_f(g0[1]) * u0[1]); w.y = cvt_pk_bf16(silu_f(g0[2]) * u0[2], silu_f(g0[3]) * u0[3]);
                w.z = cvt_pk_bf16(silu_f(g1[0]) * u1[0], silu_f(g1[1]) * u1[1]); w.w = cvt_pk_bf16(silu_f(g1[2]) * u1[2], silu_f(g1[3]) * u1[3]);
                *(u32x4*)(O + (size_t)row * LDF + col0) = w;
            }
    }
};
template <bool WRITE_XB, bool WRITE_F32 = true> struct EpiResid {
    static constexpr bool PERM = true, AFTER_DRAIN = false;
    const float* R; float* Of; bf16_t* XB; unsigned long long* ssq; float scale;
    __device__ __forceinline__ void operator()(const f32x4 (&acc)[2][2][4][2], const Unit& u, int wr, int wc, int fr, int fq) const {
        const int row0 = u.pm * BM + wr * 64 + fr, col0 = u.pn * BM + wc * 32 + 8 * fq;
#pragma unroll
        for (int ai = 0; ai < 2; ++ai)
#pragma unroll
            for (int m = 0; m < 4; ++m) {
                const int row = row0 + ai * HALF + m * 16; const size_t off = (size_t)row * D + col0; float ss = 0.f;
#pragma unroll
                for (int bj = 0; bj < 2; ++bj) {
                    const f32x4 r0 = *(const f32x4*)(R + off + bj * HALF), r1 = *(const f32x4*)(R + off + bj * HALF + 4);
                    const f32x4 h0 = r0 + acc[ai][bj][m][0] * scale, h1 = r1 + acc[ai][bj][m][1] * scale;
                    if (WRITE_F32) { *(f32x4*)(Of + off + bj * HALF) = h0; *(f32x4*)(Of + off + bj * HALF + 4) = h1; }
                    if (WRITE_XB) { u32x4 w; w.x = cvt_pk_bf16(h0[0], h0[1]); w.y = cvt_pk_bf16(h0[2], h0[3]); w.z = cvt_pk_bf16(h1[0], h1[1]); w.w = cvt_pk_bf16(h1[2], h1[3]);
                        *(u32x4*)(XB + (size_t)row * LDD + col0 + bj * HALF) = w; }
                    ss += (h0[0] * h0[0] + h0[1] * h0[1]) + (h0[2] * h0[2] + h0[3] * h0[3]) + (h1[0] * h1[0] + h1[1] * h1[1]) + (h1[2] * h1[2] + h1[3] * h1[3]);
                }
                ss += __shfl_xor(ss, 16); ss += __shfl_xor(ss, 32);
                if (fq == 0) __hip_atomic_fetch_add(ssq + row, (unsigned long long)(ss * FIXS), __ATOMIC_RELAXED, __HIP_MEMORY_SCOPE_AGENT);
                asm volatile("" ::: "memory");
            }
    }
};
struct EpiProj {
    static constexpr bool PERM = true, AFTER_DRAIN = false;
    bf16_t* O; const unsigned long long* ssq;
    __device__ __forceinline__ void operator()(const f32x4 (&acc)[2][2][4][2], const Unit& u, int wr, int wc, int fr, int fq) const {
        const int row0 = u.pm * BM + wr * 64 + fr, col0 = u.pn * BM + wc * 32 + 8 * fq;
#pragma unroll
        for (int ai = 0; ai < 2; ++ai)
#pragma unroll
            for (int m = 0; m < 4; ++m) {
                const int row = row0 + ai * HALF + m * 16; const float rs = rstd_of(ssq, row);
#pragma unroll
                for (int bj = 0; bj < 2; ++bj) { const f32x4 v0 = acc[ai][bj][m][0] * rs, v1 = acc[ai][bj][m][1] * rs;
                    u32x4 w; w.x = cvt_pk_bf16(v0[0], v0[1]); w.y = cvt_pk_bf16(v0[2], v0[3]); w.z = cvt_pk_bf16(v1[0], v1[1]); w.w = cvt_pk_bf16(v1[2], v1[3]);
                    *(u32x4*)(O + (size_t)row * LDP + col0 + bj * HALF) = w; }
            }
    }
};

struct EpiNull {
    static constexpr bool PERM = true, AFTER_DRAIN = false;
    float* sink;
    __device__ __forceinline__ void operator()(const f32x4 (&acc)[2][2][4][2], const Unit& u, int wr, int wc, int fr, int fq) const {
        float s = 0.f;
#pragma unroll
        for (int ai = 0; ai < 2; ++ai)
#pragma unroll
            for (int bj = 0; bj < 2; ++bj)
#pragma unroll
                for (int m = 0; m < 4; ++m)
#pragma unroll
                    for (int n = 0; n < 2; ++n) s += (acc[ai][bj][m][n][0] + acc[ai][bj][m][n][1]) + (acc[ai][bj][m][n][2] + acc[ai][bj][m][n][3]);
        if (s == 123456.789f) sink[u.pm * 64 + fr] = s;
    }
};
struct MaskOrder : StaticOrder {
    int mm, mn;
    __host__ __device__ bool next(int i, Unit& u) const { const bool ok = StaticOrder::next(i, u); u.pm &= mm; u.pn &= mn; return ok; }
};

#ifndef PG8_B_AUX
#define PG8_B_AUX 0
#endif
template <class Epi, class Sched, bool ALIGN_EPI = false, bool SP2 = false>
__device__ __forceinline__ void gemm_phase(PG8_LAS unsigned char* lds, const Gemm g, const Sched& S, const Epi& E, int wid) {
    const int lane = fresh_lane(), tid = wid * 64 + lane, wr = wid >> 2, wc = wid & 3, fr = lane & 15, fq = lane >> 4;
    const int K = g.K, nt = K / BK;
    unsigned voffA[2], voffB[2];
#pragma unroll
    for (int i = 0; i < 2; ++i) { int R, C; stage_rc(tid * 16 + i * 8192, R, C); const int Rb = Epi::PERM ? ((R & ~31) + perm32(R & 31)) : R;
        voffA[i] = (unsigned)(R * g.lda + C) * 2u; voffB[i] = (unsigned)(Rb * g.ldb + C) * 2u; }
    const size_t kstep = (size_t)(BK * 2);
    const size_t hstepA = (size_t)HALF * g.lda * 2, hstepB = (size_t)HALF * g.ldb * 2;
    const size_t tstepA = 2 * hstepA, tstepB = 2 * hstepB;
    const unsigned ldsw = (unsigned)wid * 1024u;
    const int aoff = lds_byte(wr * 64 + fr, fq * 8), boff = lds_byte(wc * 32 + fr, fq * 8);
#define PG8_SA(b, h) (((b) * 2 + (h)) * HTB)
#define PG8_SB(b, h) ((4 + (b) * 2 + (h)) * HTB)
#define PG8_STAGE(bufoff, gbase, voff) do { _Pragma("unroll") for (int _i = 0; _i < 2; ++_i) \
        __builtin_amdgcn_global_load_lds((const unsigned*)((const char*)(gbase) + (voff)[_i]), (PG8_LAS unsigned*)(lds + (bufoff) + ldsw + _i * 8192), 16, 0, 0); } while (0)
#define PG8_STAGE_NT(bufoff, gbase, voff) do { _Pragma("unroll") for (int _i = 0; _i < 2; ++_i) \
        __builtin_amdgcn_global_load_lds((const unsigned*)((const char*)(gbase) + (voff)[_i]), (PG8_LAS unsigned*)(lds + (bufoff) + ldsw + _i * 8192), 16, 0, PG8_B_AUX); } while (0)
#define PG8_LDA(dst, b, h) do { _Pragma("unroll") for (int m = 0; m < 4; ++m) _Pragma("unroll") for (int k = 0; k < 2; ++k) dst[m][k] = *(const PG8_LAS bf16x8*)(lds + PG8_SA(b, h) + aoff + m * 2048 + k * 1024); } while (0)
#define PG8_LDB(dst, b, h) do { _Pragma("unroll") for (int n = 0; n < 2; ++n) _Pragma("unroll") for (int k = 0; k < 2; ++k) dst[n][k] = *(const PG8_LAS bf16x8*)(lds + PG8_SB(b, h) + boff + n * 2048 + k * 1024); } while (0)
#define PG8_MMA(ai, bj, At, Bt) do { __builtin_amdgcn_s_setprio(1); _Pragma("unroll") for (int m = 0; m < 4; ++m) _Pragma("unroll") for (int n = 0; n < 2; ++n) _Pragma("unroll") for (int k = 0; k < 2; ++k) \
        acc[ai][bj][m][n] = __builtin_amdgcn_mfma_f32_16x16x32_bf16(Bt[n][k], At[m][k], acc[ai][bj][m][n], 0, 0, 0); __builtin_amdgcn_s_setprio(0); } while (0)
#define PG8_WAIT_V(n) asm volatile("s_waitcnt vmcnt(" #n ")" ::: "memory")
#define PG8_WAIT_L(n) asm volatile("s_waitcnt lgkmcnt(" #n ")" ::: "memory")
#define PG8_BAR __builtin_amdgcn_s_barrier()
#define PG8_SCHED __builtin_amdgcn_sched_barrier(0)
    Unit cur, nxt; int ui = 0;
    if (!S.next(0, cur)) return;
    f32x4 acc[2][2][4][2];
#pragma unroll
    for (int a = 0; a < 2; ++a)
#pragma unroll
        for (int b = 0; b < 2; ++b)
#pragma unroll
            for (int m = 0; m < 4; ++m)
#pragma unroll
                for (int n = 0; n < 2; ++n) acc[a][b][m][n] = (f32x4){0.f, 0.f, 0.f, 0.f};
    bf16x8 At[4][2], B0[2][2], B1[2][2];
    const char* cA = (const char*)g.A + (size_t)cur.pm * tstepA; const char* cB = (const char*)g.Bt + (size_t)cur.pn * tstepB;
    S.a_ready(cur);
    if constexpr (SP2) {
        PG8_STAGE_NT(PG8_SB(0, 0), cB, voffB); PG8_STAGE_NT(PG8_SB(0, 1), cB + hstepB, voffB); PG8_STAGE(PG8_SA(0, 0), cA, voffA); PG8_STAGE(PG8_SA(0, 1), cA + hstepA, voffA);
        if (wr == 1) PG8_BAR;
        PG8_WAIT_V(2); PG8_BAR;
        PG8_STAGE_NT(PG8_SB(1, 0), cB + kstep, voffB); PG8_STAGE(PG8_SA(1, 0), cA + kstep, voffA); PG8_STAGE_NT(PG8_SB(1, 1), cB + hstepB + kstep, voffB);
        PG8_WAIT_V(6); PG8_BAR;
    } else {
        PG8_STAGE_NT(PG8_SB(0, 0), cB, voffB); PG8_STAGE(PG8_SA(0, 0), cA, voffA); PG8_STAGE_NT(PG8_SB(0, 1), cB + hstepB, voffB); PG8_STAGE(PG8_SA(0, 1), cA + hstepA, voffA);
        if (wr == 1) PG8_BAR;
        PG8_WAIT_V(4); PG8_BAR;
        PG8_STAGE_NT(PG8_SB(1, 0), cB + kstep, voffB); PG8_STAGE(PG8_SA(1, 0), cA + kstep, voffA); PG8_STAGE_NT(PG8_SB(1, 1), cB + hstepB + kstep, voffB);
        PG8_WAIT_V(6); PG8_BAR;
    }
    for (;;) {
        const bool has_next = S.next(ui + 1, nxt);
        const char* nA = has_next ? (const char*)g.A + (size_t)nxt.pm * tstepA : cA; const char* nB = has_next ? (const char*)g.Bt + (size_t)nxt.pn * tstepB : cB;
        for (int t = 0; t < nt; t += 2) {
            const bool last = (t == nt - 2);
            const char* a1 = cA + (size_t)(t + 1) * kstep;
            const char* a2 = last ? nA : cA + (size_t)(t + 2) * kstep; const char* b2 = last ? nB : cB + (size_t)(t + 2) * kstep;
            const char* a3 = a2 + kstep; const char* b3 = b2 + kstep;
            if (last && has_next) S.a_ready(nxt);
            if constexpr (SP2) {
            PG8_LDB(B0, 0, 0); PG8_LDB(B1, 0, 1); PG8_SCHED; PG8_LDA(At, 0, 0); PG8_STAGE(PG8_SA(1, 1), a1 + hstepA, voffA);
            PG8_WAIT_V(8); PG8_WAIT_L(0); PG8_BAR; PG8_MMA(0, 0, At, B0); PG8_MMA(0, 1, At, B1); PG8_BAR; PG8_SCHED;
            PG8_LDA(At, 0, 1); PG8_STAGE_NT(PG8_SB(0, 0), b2, voffB); PG8_STAGE_NT(PG8_SB(0, 1), b2 + hstepB, voffB); PG8_STAGE(PG8_SA(0, 0), a2, voffA);
            PG8_WAIT_V(8); PG8_WAIT_L(0); PG8_BAR; PG8_MMA(1, 0, At, B0); PG8_MMA(1, 1, At, B1); PG8_BAR; PG8_SCHED;
            PG8_LDB(B0, 1, 0); PG8_LDB(B1, 1, 1); PG8_SCHED; PG8_LDA(At, 1, 0); PG8_STAGE(PG8_SA(0, 1), a2 + hstepA, voffA);
            PG8_WAIT_V(8); PG8_WAIT_L(0); PG8_BAR; PG8_MMA(0, 0, At, B0); PG8_MMA(0, 1, At, B1); PG8_BAR; PG8_SCHED;
            PG8_LDA(At, 1, 1); PG8_STAGE_NT(PG8_SB(1, 0), b3, voffB); PG8_STAGE_NT(PG8_SB(1, 1), b3 + hstepB, voffB); PG8_STAGE(PG8_SA(1, 0), a3, voffA);
            PG8_WAIT_V(8); PG8_WAIT_L(0); PG8_BAR; PG8_MMA(1, 0, At, B0); PG8_MMA(1, 1, At, B1); PG8_BAR; PG8_SCHED;
            } else {
            PG8_LDB(B0, 0, 0); PG8_SCHED; PG8_LDA(At, 0, 0); PG8_STAGE(PG8_SA(1, 1), a1 + hstepA, voffA);
            PG8_WAIT_L(8); PG8_BAR; PG8_WAIT_L(0); PG8_MMA(0, 0, At, B0); PG8_BAR; PG8_SCHED;
            PG8_LDB(B1, 0, 1); PG8_STAGE_NT(PG8_SB(0, 0), b2, voffB);
            PG8_BAR; PG8_WAIT_L(0); PG8_MMA(0, 1, At, B1); PG8_BAR;
            PG8_LDA(At, 0, 1); PG8_STAGE(PG8_SA(0, 0), a2, voffA);
            PG8_BAR; PG8_WAIT_L(0); PG8_MMA(1, 0, At, B0); PG8_BAR; PG8_SCHED;
            PG8_STAGE_NT(PG8_SB(0, 1), b2 + hstepB, voffB);
            PG8_WAIT_V(6); PG8_BAR; PG8_MMA(1, 1, At, B1); PG8_BAR;
            PG8_LDB(B0, 1, 0); PG8_SCHED; PG8_LDA(At, 1, 0); PG8_STAGE(PG8_SA(0, 1), a2 + hstepA, voffA);
            PG8_WAIT_L(8); PG8_BAR; PG8_WAIT_L(0); PG8_MMA(0, 0, At, B0); PG8_BAR; PG8_SCHED;
            PG8_LDB(B1, 1, 1); PG8_STAGE_NT(PG8_SB(1, 0), b3, voffB);
            PG8_BAR; PG8_WAIT_L(0); PG8_MMA(0, 1, At, B1); PG8_BAR;
            PG8_LDA(At, 1, 1); PG8_STAGE(PG8_SA(1, 0), a3, voffA);
            PG8_BAR; PG8_WAIT_L(0); PG8_MMA(1, 0, At, B0); PG8_BAR; PG8_SCHED;
            PG8_STAGE_NT(PG8_SB(1, 1), b3 + hstepB, voffB);
            PG8_WAIT_V(6); PG8_BAR; PG8_MMA(1, 1, At, B1); PG8_BAR;
            }
        }
        if constexpr (ALIGN_EPI) { if (wr == 0) PG8_BAR; }
        if constexpr (!Epi::AFTER_DRAIN) { E(acc, cur, wr, wc, fr, fq); S.done(cur); }
        if (!has_next) break;
#pragma unroll
        for (int a = 0; a < 2; ++a)
#pragma unroll
            for (int b = 0; b < 2; ++b)
#pragma unroll
                for (int m = 0; m < 4; ++m)
#pragma unroll
                    for (int n = 0; n < 2; ++n) acc[a][b][m][n] = (f32x4){0.f, 0.f, 0.f, 0.f};
        cur = nxt; cA = nA; cB = nB; ++ui;
        if constexpr (ALIGN_EPI) { if (wr == 1) PG8_BAR; }
    }
    PG8_WAIT_V(0);
    if constexpr (!ALIGN_EPI) { if (wr == 0) PG8_BAR; }
    PG8_BAR;
    if constexpr (Epi::AFTER_DRAIN) { E.fused(acc, cur, wr, wc, fr, fq, lds, wid, lane); S.done(cur); }
#undef PG8_SA
#undef PG8_SB
#undef PG8_STAGE
#undef PG8_STAGE_NT
#undef PG8_LDA
#undef PG8_LDB
#undef PG8_MMA
#undef PG8_WAIT_V
#undef PG8_WAIT_L
#undef PG8_BAR
#undef PG8_SCHED
}
}

constexpr size_t MiB = 1u << 20;
constexpr size_t WS_CTL = 0, CTL_ZERO_BYTES = 1 * MiB;
constexpr size_t WS_SSQ = 256 * 1024;
constexpr size_t WS_BETA = 2 * MiB, WS_G = WS_BETA + 512 * 1024, WS_GL = 3 * MiB;
constexpr size_t WS_WGU1 = 4 * MiB, WS_WD1 = WS_WGU1 + 176 * MiB, WS_WIN = WS_WD1 + 88 * MiB, WS_WOUT = WS_WIN + 115 * MiB, WS_WGU2 = WS_WOUT + 33 * MiB, WS_WD2 = WS_WGU2 + 176 * MiB;
constexpr size_t WS_XB = WS_WD2 + 88 * MiB;
constexpr size_t WS_ACT = WS_XB + 66 * MiB;
constexpr size_t WS_PROJ = WS_ACT + 174 * MiB;
constexpr size_t WS_CONCAT = WS_PROJ + 226 * MiB;
constexpr size_t WS_QN = WS_CONCAT + 66 * MiB, WS_KN = WS_QN + 32 * MiB, WS_VN = WS_KN + 32 * MiB;
constexpr size_t WS_ORAW = WS_VN + 32 * MiB;
constexpr size_t WS_END = WS_ORAW + 64 * MiB;
static_assert((size_t)2048 * 76288 <= 174 * MiB && (size_t)2 * FF * LDD * 2 <= 176 * MiB && (size_t)D * LDF * 2 <= 88 * MiB && (size_t)NPROJ * LDD * 2 <= 115 * MiB && (size_t)D * LDD * 2 <= 33 * MiB && (size_t)M * LDD * 2 <= 66 * MiB && (size_t)M * LDF * 2 <= 174 * MiB && (size_t)M * LDP * 2 <= 226 * MiB, "d_ws map");
constexpr int CW_BAR = 4096;
constexpr int CW_AQ = 8192;

constexpr int RING_BYTES = 131072;
constexpr int P0_SCR_BYTES = 8 * 64 * 65 * 4;
constexpr int LDSCTL_OFF = 163328, MISC_OFF = LDSCTL_OFF + 320;
constexpr int LDS_BYTES = 163840;
static_assert(P0_SCR_BYTES <= LDSCTL_OFF && MISC_OFF + 128 <= LDS_BYTES, "LDS map");

#define GAS __attribute__((address_space(1)))
#define LAS __attribute__((address_space(3)))
typedef unsigned short bf16;
typedef float f32x4 __attribute__((ext_vector_type(4)));
typedef float f32x2 __attribute__((ext_vector_type(2)));
typedef float f32x16 __attribute__((ext_vector_type(16)));
typedef unsigned u32x4 __attribute__((ext_vector_type(4)));
typedef unsigned u32x2 __attribute__((ext_vector_type(2)));
typedef short bf16x8 __attribute__((ext_vector_type(8)));
constexpr int NWAVES = 8;

__device__ __forceinline__ unsigned pk2(float lo, float hi) { return pg8::cvt_pk_bf16(lo, hi); }
__device__ __forceinline__ float bf_lo(unsigned w) { return __uint_as_float(w << 16); }
__device__ __forceinline__ float bf_hi(unsigned w) { return __uint_as_float(w & 0xffff0000u); }
__device__ __forceinline__ float bf2f(bf16 v) { return __uint_as_float(((unsigned)v) << 16); }
__device__ __forceinline__ float wave_sum(float v) {
#pragma unroll
    for (int o = 1; o < 64; o <<= 1) v += __shfl_xor(v, o);
    return v;
}
__device__ __forceinline__ float wave_max(float v) {
#pragma unroll
    for (int o = 1; o < 64; o <<= 1) v = fmaxf(v, __shfl_xor(v, o));
    return v;
}

#define XB_TMO      128
#define XB_XCNT(j)  (256  + 64 * (j))
#define XB_XSUB(j)  (1280 + 64 * (j))
#define XB_XGEN(j)  (2304 + 64 * (j))
#define XB_TOP      3328
#define XB_TOPGEN   3392
#define XCD_BAR_WORDS 3456
#define XB_SPIN_CAP (1u << 18)

__device__ __forceinline__ unsigned xb_ld(unsigned* p)              { return __hip_atomic_load(p, __ATOMIC_RELAXED, __HIP_MEMORY_SCOPE_AGENT); }
__device__ __forceinline__ unsigned xb_add(unsigned* p, unsigned v) { return __hip_atomic_fetch_add(p, v, __ATOMIC_RELAXED, __HIP_MEMORY_SCOPE_AGENT); }
__device__ __forceinline__ unsigned xb_xcc_id() { return (unsigned)__builtin_amdgcn_s_getreg((3 << 11) | 20) & 0xFu; }
#define XB_SPIN(cond, bar) do { unsigned _sp = 0; while (cond) { __builtin_amdgcn_s_sleep(1); \
    if ((++_sp & 255u) == 0u) { if (xb_ld(&(bar)[XB_TMO])) break; if (_sp > XB_SPIN_CAP) { atomicAdd(&(bar)[XB_TMO], 1u); break; } } } } while (0)

struct XcdBarrier {
    unsigned* bar; unsigned x;
    volatile LAS unsigned* st;
    int w;
};

__device__ __forceinline__ XcdBarrier xcd_barrier_post(unsigned* bar, volatile LAS unsigned* st) {
    XcdBarrier b; b.bar = bar; b.x = xb_xcc_id(); b.st = st;
    if (threadIdx.x == 0) (void)xb_add(&bar[XB_XCNT(b.x)], 1u);
    return b;
}
__device__ __forceinline__ void xcd_barrier_complete(unsigned* bar, unsigned x, unsigned& nloc, unsigned& nx) {
    const unsigned G = gridDim.x * gridDim.y * gridDim.z;
    unsigned sum, cnt, mine, sp = 0u;
    for (;;) {
        sum = 0u; cnt = 0u; mine = 0u;
#pragma unroll
        for (unsigned j = 0; j < 16; ++j) { const unsigned c = xb_ld(&bar[XB_XCNT(j)]); sum += c; cnt += (c > 0u) ? 1u : 0u; mine = (j == x) ? c : mine; }
        if (sum == G) break;
        __builtin_amdgcn_s_sleep(1);
        if ((++sp & 255u) == 0u) { if (xb_ld(&bar[XB_TMO])) break; if (sp > XB_SPIN_CAP) { atomicAdd(&bar[XB_TMO], 1u); break; } }
    }
    nloc = mine > 0u ? mine : 1u; nx = cnt > 0u ? cnt : 1u;
}

__device__ __forceinline__ void xcd_barrier(const XcdBarrier& b) {
    asm volatile("s_waitcnt vmcnt(0)" ::: "memory");
    __syncthreads();
    if (b.w == 0 && fresh_lane() == 0) {
        unsigned* bar = b.bar;
        __builtin_amdgcn_s_waitcnt(0);
        unsigned nloc = b.st[0], nx = b.st[1];
        if (nloc == 0u) { xcd_barrier_complete(bar, b.x, nloc, nx); b.st[0] = nloc; b.st[1] = nx; }
        const unsigned old = xb_add(&bar[XB_XSUB(b.x)], 1u);
        const unsigned gen = old / nloc;
        if (old + 1u == (gen + 1u) * nloc) {
            __builtin_amdgcn_fence(__ATOMIC_RELEASE, "agent");
            asm volatile("s_waitcnt vmcnt(0)" ::: "memory");
            const unsigned og = xb_add(&bar[XB_TOP], 1u);
            const unsigned tg = og / nx;
            if (og + 1u == (tg + 1u) * nx) xb_add(&bar[XB_TOPGEN], 1u);
            else XB_SPIN(xb_ld(&bar[XB_TOPGEN]) == tg, bar);
            __builtin_amdgcn_fence(__ATOMIC_ACQUIRE, "agent");
            xb_add(&bar[XB_XGEN(b.x)], 1u);
            asm volatile("s_waitcnt vmcnt(0)" ::: "memory");
        } else {
            XB_SPIN(xb_ld(&bar[XB_XGEN(b.x)]) == gen, bar);
            __builtin_amdgcn_fence(__ATOMIC_ACQUIRE, "agent");
            asm volatile("s_waitcnt vmcnt(0)" ::: "memory");
        }
    }
    __syncthreads();
}

#define P0T_DECL(x) const float* x##W = nullptr; const float* x##G = nullptr; bf16* x##T = nullptr; int x##K = 0, x##N = 0, x##k0 = 0, x##n0 = 0, x##ld = 0, x##blk = 0, x##off = 0
__device__ __forceinline__ void p0_load(const float* W, int N, int k0, int n0, int lane, f32x4 (&v)[16]) {
    const int c = lane & 15, rq = lane >> 4;
    int col = n0 + 4 * c; col = col < N - 4 ? col : N - 4;
    const float* p = W + (size_t)(k0 + rq) * N + col;
#pragma unroll
    for (int j = 0; j < 16; ++j) v[j] = __builtin_nontemporal_load((const f32x4*)(p + (size_t)(4 * j) * N));
}
__device__ __forceinline__ void p0_finish(bf16* WT, const float* gain, int N, int k0, int n0, int ldw, int blk, int off, int lane, const f32x4 (&v)[16], LAS float* scr) {
    const int c = lane & 15, rq = lane >> 4, c8 = lane & 7;
    f32x4 g0 = {1.f, 1.f, 1.f, 1.f}, g1 = g0;
    if (gain) { g0 = *(const f32x4*)(gain + k0 + 8 * c8); g1 = *(const f32x4*)(gain + k0 + 8 * c8 + 4); }
#pragma unroll
    for (int j = 0; j < 16; ++j) { LAS float* s = scr + (4 * j + rq) * 65 + 4 * c; s[0] = v[j][0]; s[1] = v[j][1]; s[2] = v[j][2]; s[3] = v[j][3]; }
    asm volatile("s_waitcnt lgkmcnt(0)" ::: "memory");
#pragma unroll
    for (int jj = 0; jj < 8; ++jj) { const int n = (lane >> 3) + 8 * jj; const LAS float* s = scr + (8 * c8) * 65 + n;
        u32x4 o; o.x = pk2(s[0 * 65] * g0[0], s[1 * 65] * g0[1]); o.y = pk2(s[2 * 65] * g0[2], s[3 * 65] * g0[3]); o.z = pk2(s[4 * 65] * g1[0], s[5 * 65] * g1[1]); o.w = pk2(s[6 * 65] * g1[2], s[7 * 65] * g1[3]);
        const int ng = n0 + n;
        if (ng < N) { const int row = (ng >> 7) * blk + (ng & 127) + off; __builtin_nontemporal_store(o, (u32x4*)(WT + (size_t)row * ldw + k0 + 8 * c8)); } }
    asm volatile("s_waitcnt lgkmcnt(0)" ::: "memory");
}

constexpr int ATT_KS_BYTES = 32 * 272, ATT_VS_BYTES = ATT_KS_BYTES + 32 * 320;
static_assert(8 * ATT_VS_BYTES <= LDSCTL_OFF, "attention LDS");
typedef short v4i16_t __attribute__((ext_vector_type(4)));
typedef __bf16 bf16x2_t __attribute__((ext_vector_type(2)));
__device__ __forceinline__ unsigned cvtpk_c(float lo, float hi) { f32x2 v = {lo, hi}; bf16x2_t b = __builtin_convertvector(v, bf16x2_t); return __builtin_bit_cast(unsigned, b); }
__device__ __forceinline__ bf16x8 pack_step(const f32x16& x, int s) { u32x4 p; p.x = cvtpk_c(x[8 * s], x[8 * s + 1]); p.y = cvtpk_c(x[8 * s + 2], x[8 * s + 3]); p.z = cvtpk_c(x[8 * s + 4], x[8 * s + 5]); p.w = cvtpk_c(x[8 * s + 6], x[8 * s + 7]); return __builtin_bit_cast(bf16x8, p); }
__device__ __forceinline__ v4i16_t tr16(const LAS unsigned char* p) { return __builtin_amdgcn_ds_read_tr16_b64_v4i16((LAS v4i16_t*)p); }
__device__ __forceinline__ void att_tile(const LAS unsigned char* kb, const LAS unsigned char* vb, int k0, int lq, int i, int hh, int troff,
                                         const bf16x8 (&qf)[8], f32x16 (&oacc)[4], float& mrun, float& lrun) {
    constexpr float SC = 0.08838834764831845f * 1.4426950408889634f;
    f32x16 sacc, sacc2;
#pragma unroll
    for (int r = 0; r < 16; ++r) { sacc[r] = 0.f; sacc2[r] = 0.f; }
#pragma unroll
    for (int s = 0; s < 8; s += 2) { sacc = __builtin_amdgcn_mfma_f32_32x32x16_bf16(*(const LAS bf16x8*)(kb + i * 272 + 32 * s + 16 * hh), qf[s], sacc, 0, 0, 0);
        sacc2 = __builtin_amdgcn_mfma_f32_32x32x16_bf16(*(const LAS bf16x8*)(kb + i * 272 + 32 * (s + 1) + 16 * hh), qf[s + 1], sacc2, 0, 0, 0); }
#pragma unroll
    for (int r = 0; r < 16; ++r) sacc[r] += sacc2[r];
    float tmax = -1e30f;
    const int dbase = lq - k0 - 4 * hh;
#pragma unroll
    for (int r = 0; r < 16; ++r) { const unsigned dd = (unsigned)(dbase - ((r & 3) + 8 * (r >> 2)));
        const float sv = dd <= 128u ? sacc[r] * SC : -INFINITY; sacc[r] = sv; tmax = fmaxf(tmax, sv); }
    tmax = fmaxf(tmax, __shfl_xor(tmax, 32));
    const float mnew = fmaxf(mrun, tmax);
    const float alpha = __builtin_amdgcn_exp2f(mrun - mnew);
#pragma unroll
    for (int dt = 0; dt < 4; ++dt)
#pragma unroll
        for (int r = 0; r < 16; ++r) oacc[dt][r] *= alpha;
    float psum = 0.f;
#pragma unroll
    for (int r = 0; r < 16; ++r) { const float p = __builtin_amdgcn_exp2f(sacc[r] - mnew); sacc[r] = p; psum += p; }
    psum += __shfl_xor(psum, 32);
    lrun = lrun * alpha + psum; mrun = mnew;
    const bf16x8 pf0 = pack_step(sacc, 0), pf1 = pack_step(sacc, 1);
#pragma unroll
    for (int dt = 0; dt < 4; ++dt) {
        const LAS unsigned char* vp = vb + troff + dt * 64;
        const v4i16_t a0 = tr16(vp), a1 = tr16(vp + 8 * 320), a2 = tr16(vp + 16 * 320), a3 = tr16(vp + 24 * 320);
        const bf16x8 A0 = __builtin_shufflevector(a0, a1, 0, 1, 2, 3, 4, 5, 6, 7), A1 = __builtin_shufflevector(a2, a3, 0, 1, 2, 3, 4, 5, 6, 7);
        oacc[dt] = __builtin_amdgcn_mfma_f32_32x32x16_bf16(A0, pf0, oacc[dt], 0, 0, 0);
        oacc[dt] = __builtin_amdgcn_mfma_f32_32x32x16_bf16(A1, pf1, oacc[dt], 0, 0, 0);
    }
}
__device__ __forceinline__ void attn_wg(const bf16* PROJ, bf16* CONCAT, int wu, LAS unsigned char* L, int tid, int lane, int wave) {
    const int half = wu & 1, bh = (wu >> 1) & 63, blk = 3 - (wu >> 7), h = bh & 15, b = bh >> 4;
    const int rho = 4 * (wave & 3) + 2 * half + (wave >> 2);
    const int i = lane & 31, hh = lane >> 5, l0 = blk * 32;
    const int tq = 16 * (l0 + i) + rho;
    const size_t rowbase = (size_t)b * SEQ;
    bf16x8 qf[8];
    { const bf16* qp = PROJ + (rowbase + tq) * LDP + PJ_Q + h * HD + 8 * hh;
#pragma unroll
      for (int s = 0; s < 8; ++s) qf[s] = *(const bf16x8*)(qp + 16 * s); }
    f32x16 oacc[4];
#pragma unroll
    for (int dt = 0; dt < 4; ++dt)
#pragma unroll
        for (int r = 0; r < 16; ++r) oacc[dt][r] = 0.f;
    float mrun = -1e30f, lrun = 0.f;
    const int g16 = lane >> 4, i16 = lane & 15;
    const int troff = (4 * (g16 >> 1) + (i16 >> 2)) * 320 + (16 * (g16 & 1) + 4 * (i16 & 3)) * 2;
    const bf16* kbase = PROJ + rowbase * LDP + PJ_K + h * HD;
    const bf16* vbase = PROJ + rowbase * LDP + PJ_V + h * HD;
    constexpr int TILE = ATT_VS_BYTES;
    __syncthreads();
    { const int kA = 512 * blk - 128 > 0 ? 512 * blk - 128 : 0, nt = (512 * blk + 511 - kA) / 32 + 1;
      const int row = tid >> 4, ch = tid & 15, lq = tq;
      u32x4 kr, vr;
      { int tok = kA + row; tok = tok < SEQ - 1 ? tok : SEQ - 1; kr = *(const u32x4*)(kbase + (size_t)tok * LDP + 8 * ch); vr = *(const u32x4*)(vbase + (size_t)tok * LDP + 8 * ch); }
      *(LAS u32x4*)(L + row * 272 + 16 * ch) = kr; *(LAS u32x4*)(L + ATT_KS_BYTES + row * 320 + 16 * ch) = vr;
      __syncthreads();
      for (int j = 0; j < nt; ++j) {
          const bool more = j + 1 < nt;
          if (more) { int tok = kA + 32 * (j + 1) + row; tok = tok < SEQ - 1 ? tok : SEQ - 1; kr = *(const u32x4*)(kbase + (size_t)tok * LDP + 8 * ch); vr = *(const u32x4*)(vbase + (size_t)tok * LDP + 8 * ch); }
          const LAS unsigned char* tb = L + (j & 1) * TILE;
          att_tile(tb, tb + ATT_KS_BYTES, kA + 32 * j, lq, i, hh, troff, qf, oacc, mrun, lrun);
          if (more) { LAS unsigned char* nb = L + ((j + 1) & 1) * TILE; *(LAS u32x4*)(nb + row * 272 + 16 * ch) = kr; *(LAS u32x4*)(nb + ATT_KS_BYTES + row * 320 + 16 * ch) = vr; }
          __syncthreads();
      } }
    { const int kB = 4 * l0 - 128 > 0 ? 4 * l0 - 128 : 0, nt = (4 * l0 + 127 - kB) / 32 + 1;
      const int grp = wave >> 2, tg = tid & 255, row = tg >> 3, ch = 2 * (tg & 7), rd = rho & 3, lq = 4 * (l0 + i) + (rho >> 2);
      LAS unsigned char* gb = L + grp * 2 * TILE;
      u32x4 kr0, kr1, vr0, vr1;
      { int tok = ((kB + row) << 2) + rd; tok = tok < SEQ - 1 ? tok : SEQ - 1; const bf16* kp = kbase + (size_t)tok * LDP + 8 * ch; const bf16* vp = vbase + (size_t)tok * LDP + 8 * ch;
        kr0 = *(const u32x4*)kp; kr1 = *(const u32x4*)(kp + 8); vr0 = *(const u32x4*)vp; vr1 = *(const u32x4*)(vp + 8); }
      { LAS u32x4* kd = (LAS u32x4*)(gb + row * 272 + 16 * ch); kd[0] = kr0; kd[1] = kr1; LAS u32x4* vd = (LAS u32x4*)(gb + ATT_KS_BYTES + row * 320 + 16 * ch); vd[0] = vr0; vd[1] = vr1; }
      __syncthreads();
      for (int j = 0; j < nt; ++j) {
          const bool more = j + 1 < nt;
          if (more) { int tok = ((kB + 32 * (j + 1) + row) << 2) + rd; tok = tok < SEQ - 1 ? tok : SEQ - 1; const bf16* kp = kbase + (size_t)tok * LDP + 8 * ch; const bf16* vp = vbase + (size_t)tok * LDP + 8 * ch;
              kr0 = *(const u32x4*)kp; kr1 = *(const u32x4*)(kp + 8); vr0 = *(const u32x4*)vp; vr1 = *(const u32x4*)(vp + 8); }
          const LAS unsigned char* tb = gb + (j & 1) * TILE;
          att_tile(tb, tb + ATT_KS_BYTES, kB + 32 * j, lq, i, hh, troff, qf, oacc, mrun, lrun);
          if (more) { LAS unsigned char* nb = gb + ((j + 1) & 1) * TILE; LAS u32x4* kd = (LAS u32x4*)(nb + row * 272 + 16 * ch); kd[0] = kr0; kd[1] = kr1;
              LAS u32x4* vd = (LAS u32x4*)(nb + ATT_KS_BYTES + row * 320 + 16 * ch); vd[0] = vr0; vd[1] = vr1; }
          __syncthreads();
      } }
    { const int kC = l0 - 128 > 0 ? l0 - 128 : 0, nt = (l0 + 31 - kC) / 32 + 1, lq = l0 + i;
      LAS unsigned char* wb = L + wave * TILE;
      u32x4 kst[8], vst[8];
#define ATT_LOADC(K0) do { _Pragma("unroll") for (int jj_ = 0; jj_ < 8; ++jj_) { int tok_ = (((K0) + 4 * jj_ + g16) << 4) + rho; tok_ = tok_ < SEQ - 1 ? tok_ : SEQ - 1; \
        kst[jj_] = *(const u32x4*)(kbase + (size_t)tok_ * LDP + 8 * i16); vst[jj_] = *(const u32x4*)(vbase + (size_t)tok_ * LDP + 8 * i16); } } while (0)
      for (int j = 0; j < nt; ++j) {
          ATT_LOADC(kC + 32 * j);
#pragma unroll
          for (int jj = 0; jj < 8; ++jj) { *(LAS u32x4*)(wb + (4 * jj + g16) * 272 + i16 * 16) = kst[jj]; *(LAS u32x4*)(wb + ATT_KS_BYTES + (4 * jj + g16) * 320 + i16 * 16) = vst[jj]; }
          att_tile(wb, wb + ATT_KS_BYTES, kC + 32 * j, lq, i, hh, troff, qf, oacc, mrun, lrun);
      }
#undef ATT_LOADC
    }
    const float inv = 1.0f / lrun;
    bf16* op = CONCAT + (rowbase + tq) * LDD + h * HD + 4 * hh;
#pragma unroll
    for (int dt = 0; dt < 4; ++dt)
#pragma unroll
        for (int g = 0; g < 4; ++g) { u32x2 w; w.x = cvtpk_c(oacc[dt][4 * g] * inv, oacc[dt][4 * g + 1] * inv); w.y = cvtpk_c(oacc[dt][4 * g + 2] * inv, oacc[dt][4 * g + 3] * inv);
            *(u32x2*)(op + 32 * dt + 8 * g) = w; }
}

constexpr int DN_NW = 0, DN_QD = 16896, DN_QK = 33792, DN_KDT = 42496, DN_U = 59904, DN_BLK = 76288;
constexpr int DN_GL = DN_QK + 128, DN_LBLK = 61440;
constexpr int CL_KS = 0, CL_QS = 17408, CL_KT = 34816, CL_VT = 53248, CL_AS = 71680, CL_TW = 89088, CL_TU = 98304, CL_TB = 107520, CL_QK = 116736, CL_TT = 125440, CL_A10 = 128000, CL_GC = 130560, CL_END = 131072;
static_assert(CL_END <= LDSCTL_OFF && 2 * 61440 <= LDSCTL_OFF, "DeltaNet LDS maps");
__device__ __forceinline__ int crow16(int reg, int hh) { return (reg & 3) + 8 * (reg >> 2) + 4 * hh; }
__device__ __forceinline__ bf16x8 ld_perm(const LAS unsigned char* p) {
    const v4i16_t lo = *(const LAS v4i16_t*)p, hi = *(const LAS v4i16_t*)(p + 16); return __builtin_shufflevector(lo, hi, 0, 1, 2, 3, 4, 5, 6, 7); }

__device__ __forceinline__ void dn_chunk_local(int unit, const bf16* PROJ, const float* conv_w, const float* GLOG, const float* BETA, unsigned char* blocks,
                                               LAS unsigned char* L, int tid, int lane, int wave) {
    asm volatile("" : "+v"(tid), "+v"(lane), "+s"(wave));
    const int n = unit & 31, bh = unit >> 5, h = bh & 15, b = bh >> 4, hh = lane >> 5;
    const int m0 = b * SEQ + 64 * n;
    unsigned char* blk = blocks + (size_t)unit * DN_BLK;
    LAS float* cws = (LAS float*)(L + CL_AS);
    LAS float* gcs = (LAS float*)(L + CL_GC); LAS float* betas = gcs + 64;
    for (int e = tid; e < 3 * 4 * 128; e += 512) { const int seg = e >> 9, tap = (e >> 7) & 3, ch = e & 127; cws[e] = conv_w[tap * 6144 + seg * 2048 + h * HD + ch]; }
    float gcv = GLOG[(size_t)(m0 + lane) * 16 + h];
#pragma unroll
    for (int o = 1; o < 64; o <<= 1) { const float t = __shfl_up(gcv, o); if (lane >= o) gcv += t; }
    const float gc_last = __shfl(gcv, 63);
    if (wave == 0) { gcs[lane] = gcv; betas[lane] = BETA[(size_t)(m0 + lane) * 16 + h]; }
    __syncthreads();
    { const int tt = tid >> 3, cg = tid & 7, t = 64 * n + tt;
      const float egc = __expf(__shfl(gcv, tt));
#pragma unroll
      for (int seg = 0; seg < 3; ++seg) {
          float a[16];
#pragma unroll
          for (int e = 0; e < 16; ++e) a[e] = 0.f;
#pragma unroll
          for (int tap = 0; tap < 4; ++tap) { if (t - 3 + tap >= 0) {
              const bf16* pr = PROJ + (size_t)(m0 + tt - 3 + tap) * LDP + PJ_DQKV + seg * 2048 + h * HD + 16 * cg;
              const u32x4 x0 = *(const u32x4*)pr, x1 = *(const u32x4*)(pr + 8);
              const LAS f32x4* w4 = (const LAS f32x4*)(cws + (seg * 4 + tap) * 128 + 16 * cg);
              const f32x4 w0 = w4[0], w1 = w4[1], w2 = w4[2], w3 = w4[3];
              a[0] += w0[0] * bf_lo(x0.x); a[1] += w0[1] * bf_hi(x0.x); a[2] += w0[2] * bf_lo(x0.y); a[3] += w0[3] * bf_hi(x0.y);
              a[4] += w1[0] * bf_lo(x0.z); a[5] += w1[1] * bf_hi(x0.z); a[6] += w1[2] * bf_lo(x0.w); a[7] += w1[3] * bf_hi(x0.w);
              a[8] += w2[0] * bf_lo(x1.x); a[9] += w2[1] * bf_hi(x1.x); a[10] += w2[2] * bf_lo(x1.y); a[11] += w2[3] * bf_hi(x1.y);
              a[12] += w3[0] * bf_lo(x1.z); a[13] += w3[1] * bf_hi(x1.z); a[14] += w3[2] * bf_lo(x1.w); a[15] += w3[3] * bf_hi(x1.w); } }
          float ss = 0.f;
#pragma unroll
          for (int e = 0; e < 16; ++e) { a[e] = pg8::silu_f(a[e]); ss += a[e] * a[e]; }
          if (seg < 2) { ss += __shfl_xor(ss, 1); ss += __shfl_xor(ss, 2); ss += __shfl_xor(ss, 4);
              const float rn = rsqrtf(ss + EPS) * (seg == 0 ? 0.08838834764831845f : 1.0f);
#pragma unroll
              for (int e = 0; e < 16; ++e) a[e] *= rn; }
          if (seg == 0) {
              u32x4 p0, p1; p0.x = cvtpk_c(a[0], a[1]); p0.y = cvtpk_c(a[2], a[3]); p0.z = cvtpk_c(a[4], a[5]); p0.w = cvtpk_c(a[6], a[7]);
              p1.x = cvtpk_c(a[8], a[9]); p1.y = cvtpk_c(a[10], a[11]); p1.z = cvtpk_c(a[12], a[13]); p1.w = cvtpk_c(a[14], a[15]);
              LAS u32x4* qd = (LAS u32x4*)(L + CL_QS + tt * 272 + 32 * cg); qd[0] = p0; qd[1] = p1;
              u32x2* g = (u32x2*)(blk + DN_QD + tt * 264 + 32 * cg);
              u32x2 o; o.x = cvtpk_c(a[0] * egc, a[1] * egc); o.y = cvtpk_c(a[2] * egc, a[3] * egc); g[0] = o;
              o.x = cvtpk_c(a[4] * egc, a[5] * egc); o.y = cvtpk_c(a[6] * egc, a[7] * egc); g[1] = o;
              o.x = cvtpk_c(a[8] * egc, a[9] * egc); o.y = cvtpk_c(a[10] * egc, a[11] * egc); g[2] = o;
              o.x = cvtpk_c(a[12] * egc, a[13] * egc); o.y = cvtpk_c(a[14] * egc, a[15] * egc); g[3] = o;
          } else {
              if (seg == 1) { u32x4 p0, p1; p0.x = cvtpk_c(a[0], a[1]); p0.y = cvtpk_c(a[2], a[3]); p0.z = cvtpk_c(a[4], a[5]); p0.w = cvtpk_c(a[6], a[7]);
                  p1.x = cvtpk_c(a[8], a[9]); p1.y = cvtpk_c(a[10], a[11]); p1.z = cvtpk_c(a[12], a[13]); p1.w = cvtpk_c(a[14], a[15]);
                  LAS u32x4* kd = (LAS u32x4*)(L + CL_KS + tt * 272 + 32 * cg); kd[0] = p0; kd[1] = p1; }
              LAS bf16* tp = (LAS bf16*)(L + (seg == 1 ? CL_KT : CL_VT)) + (16 * cg) * 72 + ((tt + 8 * cg) & 63);
#pragma unroll
              for (int e = 0; e < 16; ++e) tp[e * 72] = (bf16)(cvtpk_c(a[e], 0.f) & 0xffffu);
          }
      } }
    __syncthreads();
    { const int mat = wave >> 2, ti = (wave >> 1) & 1, tj = wave & 1, r = lane & 31;
      f32x16 acc;
#pragma unroll
      for (int i = 0; i < 16; ++i) acc[i] = 0.f;
      if (!(ti == 0 && tj == 1)) {
          const LAS unsigned char* ap = L + (mat == 0 ? CL_KS : CL_QS) + (32 * ti + r) * 272 + 16 * hh;
          const LAS unsigned char* bp = L + CL_KS + (32 * tj + r) * 272 + 16 * hh;
#pragma unroll
          for (int s = 0; s < 8; ++s) acc = __builtin_amdgcn_mfma_f32_32x32x16_bf16(*(const LAS bf16x8*)(ap + 32 * s), *(const LAS bf16x8*)(bp + 32 * s), acc, 0, 0, 0);
      }
      const int j = 32 * tj + r; const float gcj = gcs[j];
#pragma unroll
      for (int reg = 0; reg < 16; ++reg) { const int i = 32 * ti + crow16(reg, hh);
          const float e = (i >= j) ? __expf(gcs[i] - gcj) : 0.f;
          if (mat == 0) { const float val = (i > j) ? betas[i] * acc[reg] * e : 0.f;
              ((LAS float*)(L + CL_AS))[i * 68 + j] = val;
              if (ti == 1 && tj == 0) ((LAS bf16*)(L + CL_A10))[(i - 32) * 40 + j] = (bf16)(cvtpk_c(val, 0.f) & 0xffffu); }
          else ((LAS bf16*)(L + CL_QK))[i * 68 + j] = (bf16)(cvtpk_c(acc[reg] * e, 0.f) & 0xffffu); }
    }
    __syncthreads();
    if (wave == 0) {
        const int half = hh, c = lane & 31, cf = 32 * half + c;
        const LAS float* Ab = (const LAS float*)(L + CL_AS) + (32 * half) * 68 + 32 * half;
        float t[32];
        f32x4 cur[8], nxt[8];
#pragma unroll
        for (int q = 0; q < 8; ++q) { cur[q] = (f32x4){0.f, 0.f, 0.f, 0.f}; nxt[q] = cur[q]; }
#pragma unroll
        for (int i = 0; i < 32; ++i) {
            if (i + 1 < 32) {
#pragma unroll
                for (int j4 = 0; j4 < (i + 4) / 4; ++j4) nxt[j4] = *(const LAS f32x4*)(Ab + (i + 1) * 68 + 4 * j4); }
            float s0 = (i == c) ? 1.f : 0.f, s1 = 0.f;
#pragma unroll
            for (int j4 = 0; j4 < (i + 3) / 4; ++j4) {
#pragma unroll
                for (int e = 0; e < 4; ++e) { const int jj = 4 * j4 + e; if (jj < i) { if (jj & 1) s1 -= cur[j4][e] * t[jj]; else s0 -= cur[j4][e] * t[jj]; } } }
            t[i] = s0 + s1;
#pragma unroll
            for (int q = 0; q < 8; ++q) cur[q] = nxt[q];
            asm volatile("" : "+v"(t[i]) :: "memory");
        }
        const float csu = betas[cf], csw = csu * __expf(gcs[cf]);
        LAS bf16* Tw = (LAS bf16*)(L + CL_TW); LAS bf16* Tu = (LAS bf16*)(L + CL_TU); LAS bf16* Tb = (LAS bf16*)(L + CL_TB);
#pragma unroll
        for (int i = 0; i < 32; ++i) { const int rf = 32 * half + i;
            Tw[rf * 72 + cf] = (bf16)(cvtpk_c(t[i] * csw, 0.f) & 0xffffu); Tu[rf * 72 + cf] = (bf16)(cvtpk_c(t[i] * csu, 0.f) & 0xffffu);
            if (half == 1) { Tb[rf * 72 + cf] = (bf16)(cvtpk_c(t[i], 0.f) & 0xffffu); Tw[i * 72 + cf] = 0; Tu[i * 72 + cf] = 0; } }
        if (half == 0) { LAS u32x4* tt4 = (LAS u32x4*)(L + CL_TT + c * 80);
#pragma unroll
            for (int q = 0; q < 4; ++q) { u32x4 w; w.x = cvtpk_c(t[8 * q], t[8 * q + 1]); w.y = cvtpk_c(t[8 * q + 2], t[8 * q + 3]); w.z = cvtpk_c(t[8 * q + 4], t[8 * q + 5]); w.w = cvtpk_c(t[8 * q + 6], t[8 * q + 7]); tt4[q] = w; } }
        f32x16 xacc, tacc;
#pragma unroll
        for (int i = 0; i < 16; ++i) { xacc[i] = 0.f; tacc[i] = 0.f; }
#pragma unroll
        for (int s = 0; s < 2; ++s) xacc = __builtin_amdgcn_mfma_f32_32x32x16_bf16(*(const LAS bf16x8*)(L + CL_A10 + c * 80 + 32 * s + 16 * hh), *(const LAS bf16x8*)(L + CL_TT + c * 80 + 32 * s + 16 * hh), xacc, 0, 0, 0);
#pragma unroll
        for (int s = 0; s < 2; ++s) tacc = __builtin_amdgcn_mfma_f32_32x32x16_bf16(ld_perm(L + CL_TB + (32 + c) * 144 + (32 + 16 * s + 4 * hh) * 2), pack_step(xacc, s), tacc, 0, 0, 0);
        const float c0u = betas[c], c0w = c0u * __expf(gcs[c]);
#pragma unroll
        for (int reg = 0; reg < 16; ++reg) { const int i = 32 + crow16(reg, hh); const float v = -tacc[reg];
            Tw[i * 72 + c] = (bf16)(cvtpk_c(v * c0w, 0.f) & 0xffffu); Tu[i * 72 + c] = (bf16)(cvtpk_c(v * c0u, 0.f) & 0xffffu); }
    } else {
        const int t7 = tid - 64;
        for (int e = t7; e < 8704 / 8; e += 448) { u32x2 v = *(const LAS u32x2*)(L + CL_QK + 8 * e); if (e == 16) v.x = __float_as_uint(__expf(gc_last)); *(u32x2*)(blk + DN_QK + 8 * e) = v; }
        for (int e = t7; e < 128 * 8; e += 448) { const int dk = e >> 3, c8 = e & 7;
            const u32x4 kk = *(const LAS u32x4*)(L + CL_KT + dk * 144 + 16 * ((c8 + (dk >> 4)) & 7));
            const LAS float* gp = gcs + 8 * c8; float kd[8];
#pragma unroll
            for (int q = 0; q < 8; ++q) kd[q] = __expf(gc_last - gp[q]);
            u32x2 o0, o1; o0.x = cvtpk_c(bf_lo(kk.x) * kd[0], bf_hi(kk.x) * kd[1]); o0.y = cvtpk_c(bf_lo(kk.y) * kd[2], bf_hi(kk.y) * kd[3]);
            o1.x = cvtpk_c(bf_lo(kk.z) * kd[4], bf_hi(kk.z) * kd[5]); o1.y = cvtpk_c(bf_lo(kk.w) * kd[6], bf_hi(kk.w) * kd[7]);
            u32x2* g = (u32x2*)(blk + DN_KDT + dk * 136 + 16 * c8); g[0] = o0; g[1] = o1; }
    }
    __syncthreads();
    { const int r = lane & 31;
      { const int dkt = wave >> 1, it = wave & 1, dk = 32 * dkt + r;
        f32x16 acc;
#pragma unroll
        for (int i = 0; i < 16; ++i) acc[i] = 0.f;
#pragma unroll
        for (int s = 0; s < 4; ++s) acc = __builtin_amdgcn_mfma_f32_32x32x16_bf16(*(const LAS bf16x8*)(L + CL_KT + dk * 144 + 16 * ((2 * s + hh + (dk >> 4)) & 7)),
                                                                                  *(const LAS bf16x8*)(L + CL_TW + (32 * it + r) * 144 + 32 * s + 16 * hh), acc, 0, 0, 0);
        LAS unsigned char* wp = L + CL_KS + (32 * it + r) * 264 + (32 * dkt + 4 * hh) * 2;
#pragma unroll
        for (int g = 0; g < 4; ++g) { u32x2 w; w.x = cvtpk_c(-acc[4 * g], -acc[4 * g + 1]); w.y = cvtpk_c(-acc[4 * g + 2], -acc[4 * g + 3]); *(LAS u32x2*)(wp + 16 * g) = w; } }
      { const int it = wave >> 2, dvt = wave & 3, dv = 32 * dvt + r;
        f32x16 acc;
#pragma unroll
        for (int i = 0; i < 16; ++i) acc[i] = 0.f;
#pragma unroll
        for (int s = 0; s < 4; ++s) acc = __builtin_amdgcn_mfma_f32_32x32x16_bf16(*(const LAS bf16x8*)(L + CL_TU + (32 * it + r) * 144 + 32 * s + 16 * hh),
                                                                                  *(const LAS bf16x8*)(L + CL_VT + dv * 144 + 16 * ((2 * s + hh + (dv >> 4)) & 7)), acc, 0, 0, 0);
        u32x4 w0, w1; w0.x = cvtpk_c(acc[0], acc[1]); w0.y = cvtpk_c(acc[2], acc[3]); w0.z = cvtpk_c(acc[4], acc[5]); w0.w = cvtpk_c(acc[6], acc[7]);
        w1.x = cvtpk_c(acc[8], acc[9]); w1.y = cvtpk_c(acc[10], acc[11]); w1.z = cvtpk_c(acc[12], acc[13]); w1.w = cvtpk_c(acc[14], acc[15]);
        u32x4* up = (u32x4*)(blk + DN_U + ((dvt * 2 + it) * 64 + lane) * 32); up[0] = w0; up[1] = w1; } }
    __syncthreads();
    for (int e = tid; e < 16896 / 16; e += 512) *(u32x4*)(blk + DN_NW + 16 * e) = *(const LAS u32x4*)(L + CL_KS + 16 * e);
    __syncthreads();
}

__device__ __forceinline__ void dn_gate_rows(int bh, const float* ORAW, const bf16* PROJ, const float* dn_norm, bf16* CONCAT, int lane, int wave) {
    const int h = bh & 15, b = bh >> 4, sub = lane >> 4, c = 8 * (lane & 15);
    const f32x4 g0 = *(const f32x4*)(dn_norm + c), g1 = *(const f32x4*)(dn_norm + c + 4);
    for (int t0 = wave * 256; t0 < wave * 256 + 256; t0 += 16) {
        f32x4 o0[4], o1[4]; u32x4 zz[4];
#pragma unroll
        for (int u = 0; u < 4; ++u) { const size_t m = (size_t)b * SEQ + t0 + 4 * u + sub; const float* op = ORAW + m * 2048 + h * HD + c;
            o0[u] = *(const f32x4*)op; o1[u] = *(const f32x4*)(op + 4); zz[u] = *(const u32x4*)(PROJ + m * LDP + PJ_DZ + h * HD + c); }
#pragma unroll
        for (int u = 0; u < 4; ++u) { const size_t m = (size_t)b * SEQ + t0 + 4 * u + sub;
            float ss = (o0[u][0] * o0[u][0] + o0[u][1] * o0[u][1]) + (o0[u][2] * o0[u][2] + o0[u][3] * o0[u][3]) + (o1[u][0] * o1[u][0] + o1[u][1] * o1[u][1]) + (o1[u][2] * o1[u][2] + o1[u][3] * o1[u][3]);
            ss += __shfl_xor(ss, 1); ss += __shfl_xor(ss, 2); ss += __shfl_xor(ss, 4); ss += __shfl_xor(ss, 8);
            const float r = rsqrtf(ss * (1.0f / HD) + EPS);
            u32x4 w;
            w.x = pk2(o0[u][0] * r * g0[0] * pg8::silu_f(bf_lo(zz[u].x)), o0[u][1] * r * g0[1] * pg8::silu_f(bf_hi(zz[u].x)));
            w.y = pk2(o0[u][2] * r * g0[2] * pg8::silu_f(bf_lo(zz[u].y)), o0[u][3] * r * g0[3] * pg8::silu_f(bf_hi(zz[u].y)));
            w.z = pk2(o1[u][0] * r * g1[0] * pg8::silu_f(bf_lo(zz[u].z)), o1[u][1] * r * g1[1] * pg8::silu_f(bf_hi(zz[u].z)));
            w.w = pk2(o1[u][2] * r * g1[2] * pg8::silu_f(bf_lo(zz[u].w)), o1[u][3] * r * g1[3] * pg8::silu_f(bf_hi(zz[u].w)));
            *(u32x4*)(CONCAT + m * LDD + 2048 + h * HD + c) = w; }
    }
}
__device__ __forceinline__ void dn_scan(int bh, const unsigned char* blocks, float* ORAW, LAS unsigned char* L, int tid, int lane, int wave) {
    const int h = bh & 15, b = bh >> 4;
    const unsigned char* src = blocks + (size_t)(bh * 32) * DN_BLK;
    constexpr int NLD = DN_LBLK / 16 / 256;
    static_assert(DN_LBLK % 4096 == 0 && DN_LBLK >= DN_U && DN_LBLK <= DN_BLK, "block image");
    if (wave >= 4) {
        const int e0 = tid - 256;
        u32x4 ra[NLD], rb[NLD], rc[NLD];
#define DN_LD(R, BLKI) do { const unsigned char* sp_ = src + (size_t)((BLKI) < 31 ? (BLKI) : 31) * DN_BLK; _Pragma("unroll") for (int j_ = 0; j_ < NLD; ++j_) R[j_] = *(const u32x4*)(sp_ + 16 * e0 + 4096 * j_); } while (0)
#define DN_ST(R, P) do { LAS unsigned char* dp_ = L + (P) * DN_LBLK; _Pragma("unroll") for (int j_ = 0; j_ < NLD; ++j_) *(LAS u32x4*)(dp_ + 16 * e0 + 4096 * j_) = R[j_]; } while (0)
        DN_LD(ra, 0); DN_LD(rb, 1); DN_LD(rc, 2);
        DN_ST(ra, 0); DN_LD(ra, 3);
#define DN_STEP(N, R) do { __syncthreads(); DN_ST(R, ((N) + 1) & 1); DN_LD(R, (N) + 4); } while (0)
        for (int n = 0; n < 30; n += 3) { DN_STEP(n, rb); DN_STEP(n + 1, rc); DN_STEP(n + 2, ra); }
        DN_STEP(30, rb); DN_STEP(31, rc);
        __syncthreads();
#undef DN_STEP
#undef DN_ST
#undef DN_LD
        return;
    }
    int r = lane & 31, hh = lane >> 5;
    f32x16 Sacc[4];
#pragma unroll
    for (int t = 0; t < 4; ++t)
#pragma unroll
        for (int i = 0; i < 16; ++i) Sacc[t][i] = 0.f;
    float* op = ORAW + (size_t)(b * SEQ) * 2048 + h * HD + 32 * wave + r;
    const unsigned char* ugp = src + DN_U + ((wave * 2) * 64 + lane) * 32;
    u32x4 ua0, ua1, ua2, ua3, ub0, ub1, ub2, ub3, uc0, uc1, uc2, uc3;
#define DN_ULD(A0, A1, A2, A3, BLKI) do { const u32x4* p_ = (const u32x4*)(ugp + (size_t)((BLKI) < 31 ? (BLKI) : 31) * DN_BLK); A0 = p_[0]; A1 = p_[1]; A2 = p_[128]; A3 = p_[129]; } while (0)
    DN_ULD(ua0, ua1, ua2, ua3, 0); DN_ULD(ub0, ub1, ub2, ub3, 1); DN_ULD(uc0, uc1, uc2, uc3, 2);
    for (int n = 0; n < 32; ++n) {
        __syncthreads();
        const LAS unsigned char* B = L + (n & 1) * DN_LBLK;
        const float gl = *(const LAS float*)(B + DN_GL);
        f32x16 x0, x1;
        { const u32x4 a0 = ua0, a1 = ua1, b0 = ua2, b1 = ua3;
          x0[0] = bf_lo(a0.x); x0[1] = bf_hi(a0.x); x0[2] = bf_lo(a0.y); x0[3] = bf_hi(a0.y); x0[4] = bf_lo(a0.z); x0[5] = bf_hi(a0.z); x0[6] = bf_lo(a0.w); x0[7] = bf_hi(a0.w);
          x0[8] = bf_lo(a1.x); x0[9] = bf_hi(a1.x); x0[10] = bf_lo(a1.y); x0[11] = bf_hi(a1.y); x0[12] = bf_lo(a1.z); x0[13] = bf_hi(a1.z); x0[14] = bf_lo(a1.w); x0[15] = bf_hi(a1.w);
          x1[0] = bf_lo(b0.x); x1[1] = bf_hi(b0.x); x1[2] = bf_lo(b0.y); x1[3] = bf_hi(b0.y); x1[4] = bf_lo(b0.z); x1[5] = bf_hi(b0.z); x1[6] = bf_lo(b0.w); x1[7] = bf_hi(b0.w);
          x1[8] = bf_lo(b1.x); x1[9] = bf_hi(b1.x); x1[10] = bf_lo(b1.y); x1[11] = bf_hi(b1.y); x1[12] = bf_lo(b1.z); x1[13] = bf_hi(b1.z); x1[14] = bf_lo(b1.w); x1[15] = bf_hi(b1.w); }
        ua0 = ub0; ua1 = ub1; ua2 = ub2; ua3 = ub3; ub0 = uc0; ub1 = uc1; ub2 = uc2; ub3 = uc3; DN_ULD(uc0, uc1, uc2, uc3, n + 3);
#pragma unroll
        for (int t = 0; t < 4; ++t)
#pragma unroll
            for (int s = 0; s < 2; ++s) { const bf16x8 sb = pack_step(Sacc[t], s); const int co = (32 * t + 16 * s + 4 * hh) * 2;
                x0 = __builtin_amdgcn_mfma_f32_32x32x16_bf16(ld_perm(B + DN_NW + r * 264 + co), sb, x0, 0, 0, 0);
                x1 = __builtin_amdgcn_mfma_f32_32x32x16_bf16(ld_perm(B + DN_NW + (32 + r) * 264 + co), sb, x1, 0, 0, 0); }
        const bf16x8 v00 = pack_step(x0, 0), v01 = pack_step(x0, 1), v10 = pack_step(x1, 0), v11 = pack_step(x1, 1);
        f32x16 o0, o1;
#pragma unroll
        for (int i = 0; i < 16; ++i) { o0[i] = 0.f; o1[i] = 0.f; }
#pragma unroll
        for (int t = 0; t < 4; ++t)
#pragma unroll
            for (int s = 0; s < 2; ++s) { const bf16x8 sb = pack_step(Sacc[t], s); const int co = (32 * t + 16 * s + 4 * hh) * 2;
                o0 = __builtin_amdgcn_mfma_f32_32x32x16_bf16(ld_perm(B + DN_QD + r * 264 + co), sb, o0, 0, 0, 0);
                o1 = __builtin_amdgcn_mfma_f32_32x32x16_bf16(ld_perm(B + DN_QD + (32 + r) * 264 + co), sb, o1, 0, 0, 0); }
        o0 = __builtin_amdgcn_mfma_f32_32x32x16_bf16(ld_perm(B + DN_QK + r * 136 + (4 * hh) * 2), v00, o0, 0, 0, 0);
        o0 = __builtin_amdgcn_mfma_f32_32x32x16_bf16(ld_perm(B + DN_QK + r * 136 + (16 + 4 * hh) * 2), v01, o0, 0, 0, 0);
        o1 = __builtin_amdgcn_mfma_f32_32x32x16_bf16(ld_perm(B + DN_QK + (32 + r) * 136 + (4 * hh) * 2), v00, o1, 0, 0, 0);
        o1 = __builtin_amdgcn_mfma_f32_32x32x16_bf16(ld_perm(B + DN_QK + (32 + r) * 136 + (16 + 4 * hh) * 2), v01, o1, 0, 0, 0);
        o1 = __builtin_amdgcn_mfma_f32_32x32x16_bf16(ld_perm(B + DN_QK + (32 + r) * 136 + (32 + 4 * hh) * 2), v10, o1, 0, 0, 0);
        o1 = __builtin_amdgcn_mfma_f32_32x32x16_bf16(ld_perm(B + DN_QK + (32 + r) * 136 + (48 + 4 * hh) * 2), v11, o1, 0, 0, 0);
#pragma unroll
        for (int reg = 0; reg < 16; ++reg) { const int i = crow16(reg, hh); op[(size_t)i * 2048] = o0[reg]; op[(size_t)(32 + i) * 2048] = o1[reg]; }
#pragma unroll
        for (int t = 0; t < 4; ++t) {
#pragma unroll
            for (int i = 0; i < 16; ++i) Sacc[t][i] *= gl;
            const LAS unsigned char* kp = B + DN_KDT + (32 * t + r) * 136 + (4 * hh) * 2;
            Sacc[t] = __builtin_amdgcn_mfma_f32_32x32x16_bf16(ld_perm(kp), v00, Sacc[t], 0, 0, 0);
            Sacc[t] = __builtin_amdgcn_mfma_f32_32x32x16_bf16(ld_perm(kp + 32), v01, Sacc[t], 0, 0, 0);
            Sacc[t] = __builtin_amdgcn_mfma_f32_32x32x16_bf16(ld_perm(kp + 64), v10, Sacc[t], 0, 0, 0);
            Sacc[t] = __builtin_amdgcn_mfma_f32_32x32x16_bf16(ld_perm(kp + 96), v11, Sacc[t], 0, 0, 0); }
        op += (size_t)64 * 2048;
    }
#undef DN_ULD
    __syncthreads();
}

struct Args { const float* in[17]; float* out; unsigned char* ws; int ph_lo, ph_hi; };
constexpr int NPH = 11;

__global__ void __launch_bounds__(NWAVES * 64, 2) fwd(Args args) {
    extern __shared__ __attribute__((aligned(16))) unsigned char lds[];
    LAS unsigned char* L = (LAS unsigned char*)lds;
    volatile LAS unsigned* MISC = (volatile LAS unsigned*)(L + MISC_OFF);
    const int wave = __builtin_amdgcn_readfirstlane((int)threadIdx.x >> 6);
    int lane = fresh_lane(), tid = wave * 64 + lane;
#define REFRESH_IDS() do { lane = fresh_lane(); tid = wave * 64 + lane; } while (0)
    const int G = gridDim.x; const int bx = blockIdx.x; const int vcu = (G % 8 == 0) ? (bx % 8) * (G / 8) + bx / 8 : bx;
    const int gw = vcu * NWAVES + wave, NGW = G * NWAVES;
    unsigned char* ws = args.ws;
    unsigned* ctl = (unsigned*)(ws + WS_CTL);
    const float* x = args.in[0];
    float* out = args.out;
    unsigned long long* ssq = (unsigned long long*)(ws + WS_SSQ);
    float* BETA = (float*)(ws + WS_BETA); float* GLOG = (float*)(ws + WS_G);
    bf16* Wgu1 = (bf16*)(ws + WS_WGU1); bf16* Wd1 = (bf16*)(ws + WS_WD1); bf16* Win = (bf16*)(ws + WS_WIN); bf16* Wout = (bf16*)(ws + WS_WOUT);
    bf16* Wgu2 = (bf16*)(ws + WS_WGU2); bf16* Wd2 = (bf16*)(ws + WS_WD2);
    bf16* XB = (bf16*)(ws + WS_XB); bf16* ACT = (bf16*)(ws + WS_ACT); bf16* PROJ = (bf16*)(ws + WS_PROJ); bf16* CONCAT = (bf16*)(ws + WS_CONCAT);
    unsigned char* DNB = ws + WS_ACT; float* ORAW = (float*)(ws + WS_ORAW);

    for (int u = tid; u < (LDS_BYTES - LDSCTL_OFF) / 4; u += NWAVES * 64) ((LAS unsigned*)(L + LDSCTL_OFF))[u] = 0u;
    __syncthreads();
    XcdBarrier bar; bar.bar = ctl + CW_BAR; bar.x = 0; bar.st = nullptr; bar.w = wave;
#if ONE_LAUNCH
    bar = xcd_barrier_post(ctl + CW_BAR, MISC + 8); bar.w = wave;
#define GRID_BAR() xcd_barrier(bar)
#else
#define GRID_BAR() do { } while (0)
#endif
    const int lo = args.ph_lo, hi = args.ph_hi;
#define IN(k) (lo <= (k) && (k) < hi)
#define BOTH(k) (IN(k) && IN((k) + 1))

    constexpr int T_GU = (D / 64) * (FF / 64), T_DN = (FF / 64) * (D / 64), NT_IN = (NPROJ + 63) / 64, T_IN = (D / 64) * NT_IN, T_OUT = (D / 64) * (D / 64);
    constexpr int NITEMS = 4 * T_GU + 2 * T_DN + T_IN + T_OUT, NI0 = 2 * T_GU + T_DN + T_IN, NCB = (NITEMS - NI0) / 64;
    static_assert((NITEMS - NI0) % 64 == 0, "deferred conversion tiles come in whole batches");
#define P0T_SET(x, pw_, pg_, pt_, pk_, pn_, pkk_, pnn_, pld_, pb_, po_) do { x##W = (pw_); x##G = (pg_); x##T = (pt_); x##K = (pk_); x##N = (pn_); x##k0 = (pkk_); x##n0 = (pnn_); x##ld = (pld_); x##blk = (pb_); x##off = (po_); } while (0)
#define P0T_RESOLVE(x, item) do { int r_ = (item); \
            if (r_ < 2 * T_GU) { const int wh_ = r_ / T_GU; r_ -= wh_ * T_GU; P0T_SET(x, args.in[2 + wh_], args.in[1], Wgu1, D, FF, 64 * (r_ / (FF / 64)), 64 * (r_ % (FF / 64)), LDD, 256, 128 * wh_); break; } r_ -= 2 * T_GU; \
            if (r_ < T_DN) { P0T_SET(x, args.in[4], nullptr, Wd1, FF, D, 64 * (r_ / (D / 64)), 64 * (r_ % (D / 64)), LDF, 128, 0); break; } r_ -= T_DN; \
            if (r_ < T_IN) { P0T_SET(x, args.in[6], args.in[5], Win, D, NPROJ, 64 * (r_ / NT_IN), 64 * (r_ % NT_IN), LDD, 128, 0); break; } r_ -= T_IN; \
            if (r_ < T_OUT) { P0T_SET(x, args.in[11], nullptr, Wout, D, D, 64 * (r_ / (D / 64)), 64 * (r_ % (D / 64)), LDD, 128, 0); break; } r_ -= T_OUT; \
            if (r_ < 2 * T_GU) { const int wh_ = r_ / T_GU; r_ -= wh_ * T_GU; P0T_SET(x, args.in[13 + wh_], args.in[12], Wgu2, D, FF, 64 * (r_ / (FF / 64)), 64 * (r_ % (FF / 64)), LDD, 256, 128 * wh_); break; } r_ -= 2 * T_GU; \
            P0T_SET(x, args.in[15], nullptr, Wd2, FF, D, 64 * (r_ / (D / 64)), 64 * (r_ % (D / 64)), LDF, 128, 0); } while (0)
#define P0_RUN(first, end, stride) do { if ((first) < (end)) { \
            f32x4 va[16], vb[16]; P0T_DECL(a); P0T_DECL(b); \
            P0T_RESOLVE(a, (first)); p0_load(aW, aN, ak0, an0, lane, va); \
            for (int it = (first); it < (end); it += 2 * (stride)) {             \
                const bool hb = it + (stride) < (end); if (hb) { P0T_RESOLVE(b, it + (stride)); p0_load(bW, bN, bk0, bn0, lane, vb); } \
                p0_finish(aT, aG, aN, ak0, an0, ald, ablk, aoff, lane, va, scr); \
                if (!hb) break; \
                const bool ha = it + 2 * (stride) < (end); if (ha) { P0T_RESOLVE(a, it + 2 * (stride)); p0_load(aW, aN, ak0, an0, lane, va); } \
                p0_finish(bT, bG, bN, bk0, bn0, bld, bblk, boff, lane, vb, scr); \
            } } } while (0)
    if (IN(0)) {
        REFRESH_IDS();
        LAS float* scr = (LAS float*)(L + wave * (64 * 65 * 4));
        P0_RUN(gw, NI0, NGW);
        for (int row = gw; row < M; row += NGW) {
            const f32x4* xr = (const f32x4*)(x + (size_t)row * D) + lane; float s = 0.f;
#pragma unroll
            for (int j = 0; j < 16; ++j) { const f32x4 v = xr[64 * j]; s += (v[0] * v[0] + v[1] * v[1]) + (v[2] * v[2] + v[3] * v[3]);
                u32x2 o; o.x = pk2(v[0], v[1]); o.y = pk2(v[2], v[3]); *(u32x2*)(XB + (size_t)row * LDD + 4 * lane + 256 * j) = o; }
            s = wave_sum(s);
            if (lane == 0) ssq[row] = (unsigned long long)(s * FIXS);
        }
        if (BOTH(0)) GRID_BAR();
    }

    if (IN(1)) {
        REFRESH_IDS();
        pg8::Gemm g{XB, Wgu1, M, 2 * FF, D, LDD, LDD}; pg8::StaticOrder S; S.init(M, 2 * FF, G, bx);
        pg8::EpiGateUp E{ACT, ssq};
        pg8::gemm_phase<pg8::EpiGateUp, pg8::StaticOrder, true, true>(L, g, S, E, wave);
        if (BOTH(1)) GRID_BAR();
    }
    if (IN(2)) {
        REFRESH_IDS();
#if DEFER_AT == 2
        { LAS float* scr = (LAS float*)(L + wave * (64 * 65 * 4)); P0_RUN(NI0 + gw, NITEMS, NGW); __syncthreads(); REFRESH_IDS(); }
#endif
        pg8::Gemm g{ACT, Wd1, M, D, FF, LDF, LDF}; pg8::StaticOrder S; S.init(M, D, G, bx);
        pg8::EpiResid<true> E{x, out, XB, ssq + M, 0.5f};
        pg8::gemm_phase<pg8::EpiResid<true>, pg8::StaticOrder, true, true>(L, g, S, E, wave);
        if (BOTH(2)) GRID_BAR();
    }
    if (IN(3)) {
        REFRESH_IDS();
        {
            for (int rt = bx; rt < M / 32; rt += G) {
                const int r = lane & 31, hh = lane >> 5;
                const bf16* ap = XB + (size_t)(32 * rt + r) * LDD + wave * 512 + 8 * hh;
                const bf16* bp = Win + (size_t)(NPROJ_MAIN + r) * LDD + wave * 512 + 8 * hh;
                f32x16 acc; for (int i = 0; i < 16; ++i) acc[i] = 0.f;
#pragma unroll 8
                for (int kk = 0; kk < 32; ++kk) { const bf16x8 a = *(const bf16x8*)(ap + 16 * kk), b = *(const bf16x8*)(bp + 16 * kk);
                    acc = __builtin_amdgcn_mfma_f32_32x32x16_bf16(a, b, acc, 0, 0, 0); }
                LAS float* red = (LAS float*)L;
                __syncthreads();
#pragma unroll
                for (int i = 0; i < 16; ++i) red[(wave * 64 + lane) * 16 + i] = acc[i];
                __syncthreads();
#pragma unroll
                for (int q = 0; q < 2; ++q) { const int idx = tid + 512 * q, ln = idx >> 4, reg = idx & 15; float s = 0.f;
#pragma unroll
                    for (int w = 0; w < 8; ++w) s += red[(w * 64 + ln) * 16 + reg];
                    const int col = ln & 31, rowi = (reg & 3) + 8 * (reg >> 2) + 4 * (ln >> 5), row = 32 * rt + rowi;
                    const float val = s * pg8::rstd_of(ssq + M, row);
                    if (col < 16) BETA[row * 16 + col] = 1.0f / (1.0f + __expf(-val));
                    else { const int h = col - 16; const float z = val + args.in[9][h]; const float sp = fmaxf(z, 0.f) + log1pf(__expf(-fabsf(z)));
                        GLOG[row * 16 + h] = -__expf(args.in[8][h]) * sp; } }
            }
            __syncthreads();
        }
        pg8::Gemm g{XB, Win, M, NPROJ_MAIN, D, LDD, LDD}; pg8::StaticOrder S; S.init(M, NPROJ_MAIN, G, bx);
        pg8::EpiProj E{PROJ, ssq + M};
        pg8::gemm_phase<pg8::EpiProj, pg8::StaticOrder, true, true>(L, g, S, E, wave);
        if (BOTH(3)) GRID_BAR();
    }
    if (IN(4)) {
        REFRESH_IDS();
        for (int unit = vcu; unit < 2048; unit += G) dn_chunk_local(unit, PROJ, args.in[7], GLOG, BETA, DNB, L, tid, lane, wave);
        if (BOTH(4)) GRID_BAR();
    }
    if (IN(5)) {
        REFRESH_IDS();
        if (vcu < 64) { dn_scan(vcu, DNB, ORAW, L, tid, lane, wave);
            REFRESH_IDS(); dn_gate_rows(vcu, ORAW, PROJ, args.in[10], CONCAT, lane, wave); REFRESH_IDS(); }
        { LAS float* scr = (LAS float*)(L + wave * (64 * 65 * 4));
          for (;;) {
            __syncthreads();
            if (tid == 0) MISC[16] = __hip_atomic_fetch_add(ctl + CW_AQ, 1u, __ATOMIC_RELAXED, __HIP_MEMORY_SCOPE_AGENT);
            __syncthreads();
            constexpr int NB64 = (NCB * 3) / 4, NB16 = (NCB - NB64) * 4;
            const unsigned q = MISC[16]; if (q >= 512u + (DEFER_AT == 5 ? (unsigned)(NB64 + NB16) : 0u)) break;
            REFRESH_IDS();
#if QORDER == 0
            const bool conv = DEFER_AT == 5 ? (q < 1024u ? (q & 1u) != 0u : true) : false; const int idx = DEFER_AT == 5 ? (q < 1024u ? (int)(q >> 1) : (int)(q - 512u)) : (int)q;
#elif QORDER == 1
            const bool conv = q >= 512u; const int idx = conv ? (int)(q - 512u) : (int)q;
#else
            const bool conv = q < (unsigned)NCB; const int idx = conv ? (int)q : (int)(q - (unsigned)NCB);
#endif
            if (!conv) attn_wg(PROJ, CONCAT, idx, L, tid, lane, wave);
            else {
                const bool small = idx >= NB64; const int first = NI0 + (small ? NB64 * 64 + (idx - NB64) * 16 : idx * 64) + wave;
                f32x4 va[16], vb[16]; P0T_DECL(a); P0T_DECL(b);
#define CV_LA(k) do { P0T_RESOLVE(a, first + 8 * (k)); p0_load(aW, aN, ak0, an0, lane, va); } while (0)
#define CV_LB(k) do { P0T_RESOLVE(b, first + 8 * (k)); p0_load(bW, bN, bk0, bn0, lane, vb); } while (0)
#define CV_FA() p0_finish(aT, aG, aN, ak0, an0, ald, ablk, aoff, lane, va, scr)
#define CV_FB() p0_finish(bT, bG, bN, bk0, bn0, bld, bblk, boff, lane, vb, scr)
                if (small) { CV_LA(0); CV_LB(1); CV_FA(); CV_FB(); }
                else { CV_LA(0); CV_LB(1); CV_FA(); CV_LA(2); CV_FB(); CV_LB(3); CV_FA(); CV_LA(4); CV_FB(); CV_LB(5); CV_FA(); CV_LA(6); CV_FB(); CV_LB(7); CV_FA(); CV_FB(); }
#undef CV_LA
#undef CV_LB
#undef CV_FA
#undef CV_FB
            }
          } }
        if (BOTH(5)) GRID_BAR();
    }
    if (IN(7)) {
        REFRESH_IDS();
        pg8::Gemm g{CONCAT, Wout, M, D, D, LDD, LDD}; pg8::StaticOrder S; S.init(M, D, G, bx);
        pg8::EpiResid<true> E{out, out, XB, ssq + 2 * M, 1.0f};
        pg8::gemm_phase<pg8::EpiResid<true>, pg8::StaticOrder, true, true>(L, g, S, E, wave);
        if (BOTH(7)) GRID_BAR();
    }
    if (IN(8)) {
        REFRESH_IDS();
        pg8::Gemm g{XB, Wgu2, M, 2 * FF, D, LDD, LDD}; pg8::StaticOrder S; S.init(M, 2 * FF, G, bx);
        pg8::EpiGateUp E{ACT, ssq + 2 * M};
        pg8::gemm_phase<pg8::EpiGateUp, pg8::StaticOrder, true, true>(L, g, S, E, wave);
        if (BOTH(8)) GRID_BAR();
    }
    if (IN(9)) {
        REFRESH_IDS();
        pg8::Gemm g{ACT, Wd2, M, D, FF, LDF, LDF}; pg8::StaticOrder S; S.init(M, D, G, bx);
        pg8::EpiResid<true, false> E{out, out, XB, ssq + 3 * M, 0.5f};
        pg8::gemm_phase<pg8::EpiResid<true, false>, pg8::StaticOrder, true, true>(L, g, S, E, wave);
        if (BOTH(9)) GRID_BAR();
    }
    if (IN(10)) {
        REFRESH_IDS();
        const float* fn = args.in[16];
        for (int row = gw; row < M; row += NGW) {
            const float rs = pg8::rstd_of(ssq + 3 * M, row);
            const u32x4* hr = (const u32x4*)(XB + (size_t)row * LDD) + lane; f32x4* orow = (f32x4*)(out + (size_t)row * D) + 2 * lane; const f32x4* gp = (const f32x4*)fn + 2 * lane;
#pragma unroll
            for (int j = 0; j < 8; ++j) { const u32x4 hv = hr[64 * j]; const f32x4 g0 = gp[128 * j], g1 = gp[128 * j + 1];
                f32x4 o0, o1; o0[0] = bf_lo(hv.x) * rs * g0[0]; o0[1] = bf_hi(hv.x) * rs * g0[1]; o0[2] = bf_lo(hv.y) * rs * g0[2]; o0[3] = bf_hi(hv.y) * rs * g0[3];
                o1[0] = bf_lo(hv.z) * rs * g1[0]; o1[1] = bf_hi(hv.z) * rs * g1[1]; o1[2] = bf_lo(hv.w) * rs * g1[2]; o1[3] = bf_hi(hv.w) * rs * g1[3];
                orow[128 * j] = o0; orow[128 * j + 1] = o1; }
        }
    }
#if PROBE_BARS
    for (int r = 0; r < PROBE_BARS; ++r) GRID_BAR();
#endif
#if PROBE_X
    if (IN(11)) {
        pg8::Gemm g{XB, Wgu1, M, 2 * FF, D, LDD, LDD}; pg8::StaticOrder S; S.init(M, 2 * FF, G, bx);
        pg8::EpiNull E{(float*)(ws + WS_ORAW)};
        pg8::gemm_phase<pg8::EpiNull, pg8::StaticOrder, true, true>(L, g, S, E, wave);
    }
    if (IN(12)) {
        pg8::Gemm g{XB, Wgu1, M, 2 * FF, D, LDD, LDD}; pg8::MaskOrder S; S.init(M, 2 * FF, G, bx); S.mm = 1; S.mn = 1;
        pg8::EpiNull E{(float*)(ws + WS_ORAW)};
        pg8::gemm_phase<pg8::EpiNull, pg8::MaskOrder, true, true>(L, g, S, E, wave);
    }
    if (IN(13)) {
        pg8::Gemm g{XB, Wgu1, M, 2 * FF, D, LDD, LDD}; pg8::StaticOrder S; S.init(M, 2 * FF, G, bx);
        pg8::EpiGateUp E{ACT, ssq};
        pg8::gemm_phase<pg8::EpiGateUp, pg8::StaticOrder, true, true>(L, g, S, E, wave);
    }
    if (IN(14)) {
        pg8::Gemm g{ACT, Wd1, M, D, FF, LDF, LDF}; pg8::StaticOrder S; S.init(M, D, G, bx);
        pg8::EpiNull E{(float*)(ws + WS_ORAW)};
        pg8::gemm_phase<pg8::EpiNull, pg8::StaticOrder, true, true>(L, g, S, E, wave);
    }
#endif
#undef P0_RUN
#undef P0T_RESOLVE
#undef P0T_SET
#undef IN
#undef BOTH
}

extern "C" void kernel_launch(void* const* d_in, const int* in_sizes, int n_in, void* d_out, int out_size, void* d_ws, size_t ws_size, hipStream_t stream) {
    static int grid = 0;
    if (grid == 0) {
        if (n_in != 17 || in_sizes[0] != M * D || out_size != M * D || ws_size < WS_END) { fprintf(stderr, "kernel_launch: unexpected shapes (n_in %d, in0 %d, out %d, ws %zu < %zu); nothing launched\n", n_in, n_in > 0 ? in_sizes[0] : -1, out_size, ws_size, (size_t)WS_END); grid = -1; return; }
        int dev = 0, cus = 0, per_cu = 0;
        if (hipGetDevice(&dev) != hipSuccess || hipDeviceGetAttribute(&cus, hipDeviceAttributeMultiprocessorCount, dev) != hipSuccess) { fprintf(stderr, "kernel_launch: device query failed\n"); grid = -1; return; }
        if (hipFuncSetAttribute((const void*)fwd, hipFuncAttributeMaxDynamicSharedMemorySize, LDS_BYTES) != hipSuccess) { fprintf(stderr, "kernel_launch: hipFuncSetAttribute failed\n"); grid = -1; return; }
        if (hipOccupancyMaxActiveBlocksPerMultiprocessor(&per_cu, (const void*)fwd, NWAVES * 64, LDS_BYTES) != hipSuccess || per_cu < 1) fprintf(stderr, "kernel_launch: note: occupancy query reports %d workgroups per CU\n", per_cu);
        (void)hipGetLastError();
        grid = cus;
    }
    if (grid < 0) return;
    if (hipMemsetAsync((char*)d_ws + WS_CTL, 0, CTL_ZERO_BYTES, stream) != hipSuccess) { fprintf(stderr, "kernel_launch: memset failed\n"); return; }
    Args a{};
    for (int i = 0; i < 17; ++i) a.in[i] = (const float*)d_in[i];
    a.out = (float*)d_out; a.ws = (unsigned char*)d_ws;
#if ONE_LAUNCH
    a.ph_lo = 0; a.ph_hi = NPH;
    hipLaunchKernelGGL(fwd, dim3(grid), dim3(NWAVES * 64), LDS_BYTES, stream, a);
#else
    for (int k = 0; k < NPH; ++k) { a.ph_lo = k; a.ph_hi = k + 1; for (int r = 0; r < (k == PROBE_REP ? 2 : 1); ++r) { if (r == 1 && PROBE_RESETQ) (void)hipMemsetAsync((char*)d_ws + CW_AQ * 4, 0, 4, stream); hipLaunchKernelGGL(fwd, dim3(grid), dim3(NWAVES * 64), LDS_BYTES, stream, a); } }
#endif
#if PROBE_X
    a.ph_lo = 10 + PROBE_X; a.ph_hi = 11 + PROBE_X; hipLaunchKernelGGL(fwd, dim3(grid), dim3(NWAVES * 64), LDS_BYTES, stream, a);
#endif
    const hipError_t le = hipPeekAtLastError();
    if (le != hipSuccess) fprintf(stderr, "kernel_launch: launch failed: %s\n", hipGetErrorName(le));
}
```

```cpp
#include <hip/hip_runtime.h>
#include <cstdio>
#include <cstdint>

#ifndef ONE_LAUNCH
#define ONE_LAUNCH 1
#endif
#ifndef PROBE_X
#define PROBE_X 0
#endif
#ifndef PROBE_RESETQ
#define PROBE_RESETQ 0
#endif
#ifndef DEFER_AT
#define DEFER_AT 5
#endif
#ifndef PROBE_BARS
#define PROBE_BARS 0
#endif
#ifndef QORDER
#define QORDER 1
#endif
#ifndef PROBE_REP
#define PROBE_REP -1
#endif

constexpr int M = 8192, SEQ = 2048, D = 4096, FF = 11008, NPROJ = 14368, NPROJ_MAIN = 14336, NH = 16, HD = 128;
constexpr int PJ_Q = 0, PJ_K = 2048, PJ_V = 4096, PJ_DQKV = 6144, PJ_DZ = 12288;
constexpr int LDD = D + 64, LDF = FF + 64, LDP = NPROJ_MAIN + 64;
constexpr float FIXS = 16777216.0f;
constexpr float EPS = 1e-6f;

__device__ __forceinline__ int fresh_lane() { int l; asm volatile("v_mbcnt_lo_u32_b32 %0, -1, 0\n\tv_mbcnt_hi_u32_b32 %0, -1, %0" : "=v"(l)); return l; }

namespace pg8 {
#define PG8_LAS __attribute__((address_space(3)))
typedef unsigned short bf16_t;
typedef short bf16x8 __attribute__((ext_vector_type(8)));
typedef float f32x4 __attribute__((ext_vector_type(4)));
typedef unsigned u32x4 __attribute__((ext_vector_type(4)));
constexpr int BM = 256, BK = 64, HALF = 128, HTB = HALF * BK * 2  , STAGE_BYTES = 8 * HTB, NXCD = 8, WGM = 8;

__host__ __device__ __forceinline__ int lds_byte(int r, int c) { const int st = (r >> 4) * 2 + (c >> 5), rr = r & 15, cc = c & 31, ob = rr * 64 + cc * 2; return st * 1024 + (ob ^ (((ob >> 9) & 1) << 5)); }
__host__ __device__ __forceinline__ void stage_rc(int b, int& R, int& C) { const int st = b / 1024, sb = b % 1024, swz = sb ^ (((sb >> 9) & 1) << 5); R = (st >> 1) * 16 + swz / 64; C = (st & 1) * 32 + (swz % 64) / 2; }
__host__ __device__ __forceinline__ int perm32(int rho) { const int n = rho >> 4, i = rho & 15; return 8 * (i >> 2) + 4 * n + (i & 3); }

struct Unit { int pm, pn; };
struct Gemm { const bf16_t* A; const bf16_t* Bt; int M, N, K, lda, ldb; };

struct StaticOrder {
    int nM, nN, nwg, G, c;
    __host__ __device__ void init(int M, int N, int G_, int c_) { nM = M / BM; nN = N / BM; nwg = nM * nN; G = G_; c = c_; }
    __host__ __device__ bool next(int i, Unit& u) const {
        const long L = (long)i * G + c; if (L >= nwg) return false;
        int wgid = (int)L; { const int q = nwg / NXCD, r = nwg % NXCD, xcd = wgid % NXCD, off = wgid / NXCD; wgid = (xcd < r ? xcd * (q + 1) : r * (q + 1) + (xcd - r) * q) + off; }
        const int nig = WGM * nN, gid = wgid / nig, fm = gid * WGM, gsz = (nM - fm) < WGM ? (nM - fm) : WGM;
        u.pm = fm + ((wgid % nig) % gsz); u.pn = (wgid % nig) / gsz; return true;
    }
    __device__ __forceinline__ void a_ready(const Unit&) const {}
    __device__ __forceinline__ void done(const Unit&) const {}
};

__device__ __forceinline__ unsigned cvt_pk_bf16(float lo, float hi) { unsigned r; asm volatile("v_cvt_pk_bf16_f32 %0, %1, %2" : "=v"(r) : "v"(lo), "v"(hi)); return r; }
typedef float f32x2 __attribute__((ext_vector_type(2)));

__device__ __forceinline__ float rstd_of(const unsigned long long* ssq, int row) {
    const unsigned long long q = ssq[row];
    const float s = (float)q * (1.0f / FIXS);
    return rsqrtf(s * (1.0f / (float)D) + EPS);
}
__device__ __forceinline__ float silu_f(float x) { return x * __builtin_amdgcn_rcpf(1.0f + __expf(-x)); }

struct EpiGateUp {
    static constexpr bool PERM = true, AFTER_DRAIN = false;
    bf16_t* O; const unsigned long long* ssq;
    __device__ __forceinline__ void operator()(const f32x4 (&acc)[2][2][4][2], const Unit& u, int wr, int wc, int fr, int fq) const {
        const int row0 = u.pm * BM + wr * 64 + fr, col0 = u.pn * HALF + wc * 32 + 8 * fq;
#pragma unroll
        for (int ai = 0; ai < 2; ++ai)
#pragma unroll
            for (int m = 0; m < 4; ++m) {
                const int row = row0 + ai * HALF + m * 16; const float rs = rstd_of(ssq, row);
                const f32x4 g0 = acc[ai][0][m][0] * rs, g1 = acc[ai][0][m][1] * rs, u0 = acc[ai][1][m][0] * rs, u1 = acc[ai][1][m][1] * rs;
                u32x4 w;
                w.x = cvt_pk_bf16(silu_f(g0[0]) * u0[0], silu_f(g0[1]) * u0[1]); w.y = cvt_pk_bf16(silu_f(g0[2]) * u0[2], silu_f(g0[3]) * u0[3]);
                w.z = cvt_pk_bf16(silu_f(g1[0]) * u1[0], silu_f(g1[1]) * u1[1]); w.w = cvt_pk_bf16(silu_f(g1[2]) * u1[2], silu_f(g1[3]) * u1[3]);
                *(u32x4*)(O + (size_t)row * LDF + col0) = w;
            }
    }
};
template <bool WRITE_XB, bool WRITE_F32 = true> struct EpiResid {
    static constexpr bool PERM = true, AFTER_DRAIN = false;
    const float* R; float* Of; bf16_t* XB; unsigned long long* ssq; float scale;
    __device__ __forceinline__ void operator()(const f32x4 (&acc)[2][2][4][2], const Unit& u, int wr, int wc, int fr, int fq) const {
        const int row0 = u.pm * BM + wr * 64 + fr, col0 = u.pn * BM + wc * 32 + 8 * fq;
#pragma unroll
        for (int ai = 0; ai < 2; ++ai)
#pragma unroll
            for (int m = 0; m < 4; ++m) {
                const int row = row0 + ai * HALF + m * 16; const size_t off = (size_t)row * D + col0; float ss = 0.f;
#pragma unroll
                for (int bj = 0; bj < 2; ++bj) {
                    const f32x4 r0 = *(const f32x4*)(R + off + bj * HALF), r1 = *(const f32x4*)(R + off + bj * HALF + 4);
                    const f32x4 h0 = r0 + acc[ai][bj][m][0] * scale, h1 = r1 + acc[ai][bj][m][1] * scale;
                    if (WRITE_F32) { *(f32x4*)(Of + off + bj * HALF) = h0; *(f32x4*)(Of + off + bj * HALF + 4) = h1; }
                    if (WRITE_XB) { u32x4 w; w.x = cvt_pk_bf16(h0[0], h0[1]); w.y = cvt_pk_bf16(h0[2], h0[3]); w.z = cvt_pk_bf16(h1[0], h1[1]); w.w = cvt_pk_bf16(h1[2], h1[3]);
                        *(u32x4*)(XB + (size_t)row * LDD + col0 + bj * HALF) = w; }
                    ss += (h0[0] * h0[0] + h0[1] * h0[1]) + (h0[2] * h0[2] + h0[3] * h0[3]) + (h1[0] * h1[0] + h1[1] * h1[1]) + (h1[2] * h1[2] + h1[3] * h1[3]);
                }
                ss += __shfl_xor(ss, 16); ss += __shfl_xor(ss, 32);
                if (fq == 0) __hip_atomic_fetch_add(ssq + row, (unsigned long long)(ss * FIXS), __ATOMIC_RELAXED, __HIP_MEMORY_SCOPE_AGENT);
                asm volatile("" ::: "memory");
            }
    }
};
struct EpiProj {
    static constexpr bool PERM = true, AFTER_DRAIN = false;
    bf16_t* O; const unsigned long long* ssq;
    __device__ __forceinline__ void operator()(const f32x4 (&acc)[2][2][4][2], const Unit& u, int wr, int wc, int fr, int fq) const {
        const int row0 = u.pm * BM + wr * 64 + fr, col0 = u.pn * BM + wc * 32 + 8 * fq;
#pragma unroll
        for (int ai = 0; ai < 2; ++ai)
#pragma unroll
            for (int m = 0; m < 4; ++m) {
                const int row = row0 + ai * HALF + m * 16; const float rs = rstd_of(ssq, row);
#pragma unroll
                for (int bj = 0; bj < 2; ++bj) { const f32x4 v0 = acc[ai][bj][m][0] * rs, v1 = acc[ai][bj][m][1] * rs;
                    u32x4 w; w.x = cvt_pk_bf16(v0[0], v0[1]); w.y = cvt_pk_bf16(v0[2], v0[3]); w.z = cvt_pk_bf16(v1[0], v1[1]); w.w = cvt_pk_bf16(v1[2], v1[3]);
                    *(u32x4*)(O + (size_t)row * LDP + col0 + bj * HALF) = w; }
            }
    }
};

struct EpiNull {
    static constexpr bool PERM = true, AFTER_DRAIN = false;
    float* sink;
    __device__ __forceinline__ void operator()(const f32x4 (&acc)[2][2][4][2], const Unit& u, int wr, int wc, int fr, int fq) const {
        float s = 0.f;
#pragma unroll
        for (int ai = 0; ai < 2; ++ai)
#pragma unroll
            for (int bj = 0; bj < 2; ++bj)
#pragma unroll
                for (int m = 0; m < 4; ++m)
#pragma unroll
                    for (int n = 0; n < 2; ++n) s += (acc[ai][bj][m][n][0] + acc[ai][bj][m][n][1]) + (acc[ai][bj][m][n][2] + acc[ai][bj][m][n][3]);
        if (s == 123456.789f) sink[u.pm * 64 + fr] = s;
    }
};
struct MaskOrder : StaticOrder {
    int mm, mn;
    __host__ __device__ bool next(int i, Unit& u) const { const bool ok = StaticOrder::next(i, u); u.pm &= mm; u.pn &= mn; return ok; }
};

#ifndef PG8_B_AUX
#define PG8_B_AUX 0
#endif
template <class Epi, class Sched, bool ALIGN_EPI = false, bool SP2 = false>
__device__ __forceinline__ void gemm_phase(PG8_LAS unsigned char* lds, const Gemm g, const Sched& S, const Epi& E, int wid) {
    const int lane = fresh_lane(), tid = wid * 64 + lane, wr = wid >> 2, wc = wid & 3, fr = lane & 15, fq = lane >> 4;
    const int K = g.K, nt = K / BK;
    unsigned voffA[2], voffB[2];
#pragma unroll
    for (int i = 0; i < 2; ++i) { int R, C; stage_rc(tid * 16 + i * 8192, R, C); const int Rb = Epi::PERM ? ((R & ~31) + perm32(R & 31)) : R;
        voffA[i] = (unsigned)(R * g.lda + C) * 2u; voffB[i] = (unsigned)(Rb * g.ldb + C) * 2u; }
    const size_t kstep = (size_t)(BK * 2);
    const size_t hstepA = (size_t)HALF * g.lda * 2, hstepB = (size_t)HALF * g.ldb * 2;
    const size_t tstepA = 2 * hstepA, tstepB = 2 * hstepB;
    const unsigned ldsw = (unsigned)wid * 1024u;
    const int aoff = lds_byte(wr * 64 + fr, fq * 8), boff = lds_byte(wc * 32 + fr, fq * 8);
#define PG8_SA(b, h) (((b) * 2 + (h)) * HTB)
#define PG8_SB(b, h) ((4 + (b) * 2 + (h)) * HTB)
#define PG8_STAGE(bufoff, gbase, voff) do { _Pragma("unroll") for (int _i = 0; _i < 2; ++_i) \
        __builtin_amdgcn_global_load_lds((const unsigned*)((const char*)(gbase) + (voff)[_i]), (PG8_LAS unsigned*)(lds + (bufoff) + ldsw + _i * 8192), 16, 0, 0); } while (0)
#define PG8_STAGE_NT(bufoff, gbase, voff) do { _Pragma("unroll") for (int _i = 0; _i < 2; ++_i) \
        __builtin_amdgcn_global_load_lds((const unsigned*)((const char*)(gbase) + (voff)[_i]), (PG8_LAS unsigned*)(lds + (bufoff) + ldsw + _i * 8192), 16, 0, PG8_B_AUX); } while (0)
#define PG8_LDA(dst, b, h) do { _Pragma("unroll") for (int m = 0; m < 4; ++m) _Pragma("unroll") for (int k = 0; k < 2; ++k) dst[m][k] = *(const PG8_LAS bf16x8*)(lds + PG8_SA(b, h) + aoff + m * 2048 + k * 1024); } while (0)
#define PG8_LDB(dst, b, h) do { _Pragma("unroll") for (int n = 0; n < 2; ++n) _Pragma("unroll") for (int k = 0; k < 2; ++k) dst[n][k] = *(const PG8_LAS bf16x8*)(lds + PG8_SB(b, h) + boff + n * 2048 + k * 1024); } while (0)
#define PG8_MMA(ai, bj, At, Bt) do { __builtin_amdgcn_s_setprio(1); _Pragma("unroll") for (int m = 0; m < 4; ++m) _Pragma("unroll") for (int n = 0; n < 2; ++n) _Pragma("unroll") for (int k = 0; k < 2; ++k) \
        acc[ai][bj][m][n] = __builtin_amdgcn_mfma_f32_16x16x32_bf16(Bt[n][k], At[m][k], acc[ai][bj][m][n], 0, 0, 0); __builtin_amdgcn_s_setprio(0); } while (0)
#define PG8_WAIT_V(n) asm volatile("s_waitcnt vmcnt(" #n ")" ::: "memory")
#define PG8_WAIT_L(n) asm volatile("s_waitcnt lgkmcnt(" #n ")" ::: "memory")
#define PG8_BAR __builtin_amdgcn_s_barrier()
#define PG8_SCHED __builtin_amdgcn_sched_barrier(0)
    Unit cur, nxt; int ui = 0;
    if (!S.next(0, cur)) return;
    f32x4 acc[2][2][4][2];
#pragma unroll
    for (int a = 0; a < 2; ++a)
#pragma unroll
        for (int b = 0; b < 2; ++b)
#pragma unroll
            for (int m = 0; m < 4; ++m)
#pragma unroll
                for (int n = 0; n < 2; ++n) acc[a][b][m][n] = (f32x4){0.f, 0.f, 0.f, 0.f};
    bf16x8 At[4][2], B0[2][2], B1[2][2];
    const char* cA = (const char*)g.A + (size_t)cur.pm * tstepA; const char* cB = (const char*)g.Bt + (size_t)cur.pn * tstepB;
    S.a_ready(cur);
    if constexpr (SP2) {
        PG8_STAGE_NT(PG8_SB(0, 0), cB, voffB); PG8_STAGE_NT(PG8_SB(0, 1), cB + hstepB, voffB); PG8_STAGE(PG8_SA(0, 0), cA, voffA); PG8_STAGE(PG8_SA(0, 1), cA + hstepA, voffA);
        if (wr == 1) PG8_BAR;
        PG8_WAIT_V(2); PG8_BAR;
        PG8_STAGE_NT(PG8_SB(1, 0), cB + kstep, voffB); PG8_STAGE(PG8_SA(1, 0), cA + kstep, voffA); PG8_STAGE_NT(PG8_SB(1, 1), cB + hstepB + kstep, voffB);
        PG8_WAIT_V(6); PG8_BAR;
    } else {
        PG8_STAGE_NT(PG8_SB(0, 0), cB, voffB); PG8_STAGE(PG8_SA(0, 0), cA, voffA); PG8_STAGE_NT(PG8_SB(0, 1), cB + hstepB, voffB); PG8_STAGE(PG8_SA(0, 1), cA + hstepA, voffA);
        if (wr == 1) PG8_BAR;
        PG8_WAIT_V(4); PG8_BAR;
        PG8_STAGE_NT(PG8_SB(1, 0), cB + kstep, voffB); PG8_STAGE(PG8_SA(1, 0), cA + kstep, voffA); PG8_STAGE_NT(PG8_SB(1, 1), cB + hstepB + kstep, voffB);
        PG8_WAIT_V(6); PG8_BAR;
    }
    for (;;) {
        const bool has_next = S.next(ui + 1, nxt);
        const char* nA = has_next ? (const char*)g.A + (size_t)nxt.pm * tstepA : cA; const char* nB = has_next ? (const char*)g.Bt + (size_t)nxt.pn * tstepB : cB;
        for (int t = 0; t < nt; t += 2) {
            const bool last = (t == nt - 2);
            const char* a1 = cA + (size_t)(t + 1) * kstep;
            const char* a2 = last ? nA : cA + (size_t)(t + 2) * kstep; const char* b2 = last ? nB : cB + (size_t)(t + 2) * kstep;
            const char* a3 = a2 + kstep; const char* b3 = b2 + kstep;
            if (last && has_next) S.a_ready(nxt);
            if constexpr (SP2) {
            PG8_LDB(B0, 0, 0); PG8_LDB(B1, 0, 1); PG8_SCHED; PG8_LDA(At, 0, 0); PG8_STAGE(PG8_SA(1, 1), a1 + hstepA, voffA);
            PG8_WAIT_V(8); PG8_WAIT_L(0); PG8_BAR; PG8_MMA(0, 0, At, B0); PG8_MMA(0, 1, At, B1); PG8_BAR; PG8_SCHED;
            PG8_LDA(At, 0, 1); PG8_STAGE_NT(PG8_SB(0, 0), b2, voffB); PG8_STAGE_NT(PG8_SB(0, 1), b2 + hstepB, voffB); PG8_STAGE(PG8_SA(0, 0), a2, voffA);
            PG8_WAIT_V(8); PG8_WAIT_L(0); PG8_BAR; PG8_MMA(1, 0, At, B0); PG8_MMA(1, 1, At, B1); PG8_BAR; PG8_SCHED;
            PG8_LDB(B0, 1, 0); PG8_LDB(B1, 1, 1); PG8_SCHED; PG8_LDA(At, 1, 0); PG8_STAGE(PG8_SA(0, 1), a2 + hstepA, voffA);
            PG8_WAIT_V(8); PG8_WAIT_L(0); PG8_BAR; PG8_MMA(0, 0, At, B0); PG8_MMA(0, 1, At, B1); PG8_BAR; PG8_SCHED;
            PG8_LDA(At, 1, 1); PG8_STAGE_NT(PG8_SB(1, 0), b3, voffB); PG8_STAGE_NT(PG8_SB(1, 1), b3 + hstepB, voffB); PG8_STAGE(PG8_SA(1, 0), a3, voffA);
            PG8_WAIT_V(8); PG8_WAIT_L(0); PG8_BAR; PG8_MMA(1, 0, At, B0); PG8_MMA(1, 1, At, B1); PG8_BAR; PG8_SCHED;
            } else {
            PG8_LDB(B0, 0, 0); PG8_SCHED; PG8_LDA(At, 0, 0); PG8_STAGE(PG8_SA(1, 1), a1 + hstepA, voffA);
            PG8_WAIT_L(8); PG8_BAR; PG8_WAIT_L(0); PG8_MMA(0, 0, At, B0); PG8_BAR; PG8_SCHED;
            PG8_LDB(B1, 0, 1); PG8_STAGE_NT(PG8_SB(0, 0), b2, voffB);
            PG8_BAR; PG8_WAIT_L(0); PG8_MMA(0, 1, At, B1); PG8_BAR;
            PG8_LDA(At, 0, 1); PG8_STAGE(PG8_SA(0, 0), a2, voffA);
            PG8_BAR; PG8_WAIT_L(0); PG8_MMA(1, 0, At, B0); PG8_BAR; PG8_SCHED;
            PG8_STAGE_NT(PG8_SB(0, 1), b2 + hstepB, voffB);
            PG8_WAIT_V(6); PG8_BAR; PG8_MMA(1, 1, At, B1); PG8_BAR;
            PG8_LDB(B0, 1, 0); PG8_SCHED; PG8_LDA(At, 1, 0); PG8_STAGE(PG8_SA(0, 1), a2 + hstepA, voffA);
            PG8_WAIT_L(8); PG8_BAR; PG8_WAIT_L(0); PG8_MMA(0, 0, At, B0); PG8_BAR; PG8_SCHED;
            PG8_LDB(B1, 1, 1); PG8_STAGE_NT(PG8_SB(1, 0), b3, voffB);
            PG8_BAR; PG8_WAIT_L(0); PG8_MMA(0, 1, At, B1); PG8_BAR;
            PG8_LDA(At, 1, 1); PG8_STAGE(PG8_SA(1, 0), a3, voffA);
            PG8_BAR; PG8_WAIT_L(0); PG8_MMA(1, 0, At, B0); PG8_BAR; PG8_SCHED;
            PG8_STAGE_NT(PG8_SB(1, 1), b3 + hstepB, voffB);
            PG8_WAIT_V(6); PG8_BAR; PG8_MMA(1, 1, At, B1); PG8_BAR;
            }
        }
        if constexpr (ALIGN_EPI) { if (wr == 0) PG8_BAR; }
        if constexpr (!Epi::AFTER_DRAIN) { E(acc, cur, wr, wc, fr, fq); S.done(cur); }
        if (!has_next) break;
#pragma unroll
        for (int a = 0; a < 2; ++a)
#pragma unroll
            for (int b = 0; b < 2; ++b)
#pragma unroll
                for (int m = 0; m < 4; ++m)
#pragma unroll
                    for (int n = 0; n < 2; ++n) acc[a][b][m][n] = (f32x4){0.f, 0.f, 0.f, 0.f};
        cur = nxt; cA = nA; cB = nB; ++ui;
        if constexpr (ALIGN_EPI) { if (wr == 1) PG8_BAR; }
    }
    PG8_WAIT_V(0);
    if constexpr (!ALIGN_EPI) { if (wr == 0) PG8_BAR; }
    PG8_BAR;
    if constexpr (Epi::AFTER_DRAIN) { E.fused(acc, cur, wr, wc, fr, fq, lds, wid, lane); S.done(cur); }
#undef PG8_SA
#undef PG8_SB
#undef PG8_STAGE
#undef PG8_STAGE_NT
#undef PG8_LDA
#undef PG8_LDB
#undef PG8_MMA
#undef PG8_WAIT_V
#undef PG8_WAIT_L
#undef PG8_BAR
#undef PG8_SCHED
}
}

constexpr size_t MiB = 1u << 20;
constexpr size_t WS_CTL = 0, CTL_ZERO_BYTES = 1 * MiB;
constexpr size_t WS_SSQ = 256 * 1024;
constexpr size_t WS_BETA = 2 * MiB, WS_G = WS_BETA + 512 * 1024, WS_GL = 3 * MiB;
constexpr size_t WS_WGU1 = 4 * MiB, WS_WD1 = WS_WGU1 + 176 * MiB, WS_WIN = WS_WD1 + 88 * MiB, WS_WOUT = WS_WIN + 115 * MiB, WS_WGU2 = WS_WOUT + 33 * MiB, WS_WD2 = WS_WGU2 + 176 * MiB;
constexpr size_t WS_XB = WS_WD2 + 88 * MiB;
constexpr size_t WS_ACT = WS_XB + 66 * MiB;
constexpr size_t WS_PROJ = WS_ACT + 174 * MiB;
constexpr size_t WS_CONCAT = WS_PROJ + 226 * MiB;
constexpr size_t WS_QN = WS_CONCAT + 66 * MiB, WS_KN = WS_QN + 32 * MiB, WS_VN = WS_KN + 32 * MiB;
constexpr size_t WS_ORAW = WS_VN + 32 * MiB;
constexpr size_t WS_END = WS_ORAW + 64 * MiB;
static_assert((size_t)2048 * 76288 <= 174 * MiB && (size_t)2 * FF * LDD * 2 <= 176 * MiB && (size_t)D * LDF * 2 <= 88 * MiB && (size_t)NPROJ * LDD * 2 <= 115 * MiB && (size_t)D * LDD * 2 <= 33 * MiB && (size_t)M * LDD * 2 <= 66 * MiB && (size_t)M * LDF * 2 <= 174 * MiB && (size_t)M * LDP * 2 <= 226 * MiB, "d_ws map");
constexpr int CW_BAR = 4096;
constexpr int CW_AQ = 8192;

constexpr int RING_BYTES = 131072;
constexpr int P0_SCR_BYTES = 8 * 64 * 65 * 4;
constexpr int LDSCTL_OFF = 163328, MISC_OFF = LDSCTL_OFF + 320;
constexpr int LDS_BYTES = 163840;
static_assert(P0_SCR_BYTES <= LDSCTL_OFF && MISC_OFF + 128 <= LDS_BYTES, "LDS map");

#define GAS __attribute__((address_space(1)))
#define LAS __attribute__((address_space(3)))
typedef unsigned short bf16;
typedef float f32x4 __attribute__((ext_vector_type(4)));
typedef float f32x2 __attribute__((ext_vector_type(2)));
typedef float f32x16 __attribute__((ext_vector_type(16)));
typedef unsigned u32x4 __attribute__((ext_vector_type(4)));
typedef unsigned u32x2 __attribute__((ext_vector_type(2)));
typedef short bf16x8 __attribute__((ext_vector_type(8)));
constexpr int NWAVES = 8;

__device__ __forceinline__ unsigned pk2(float lo, float hi) { return pg8::cvt_pk_bf16(lo, hi); }
__device__ __forceinline__ float bf_lo(unsigned w) { return __uint_as_float(w << 16); }
__device__ __forceinline__ float bf_hi(unsigned w) { return __uint_as_float(w & 0xffff0000u); }
__device__ __forceinline__ float bf2f(bf16 v) { return __uint_as_float(((unsigned)v) << 16); }
__device__ __forceinline__ float wave_sum(float v) {
#pragma unroll
    for (int o = 1; o < 64; o <<= 1) v += __shfl_xor(v, o);
    return v;
}
__device__ __forceinline__ float wave_max(float v) {
#pragma unroll
    for (int o = 1; o < 64; o <<= 1) v = fmaxf(v, __shfl_xor(v, o));
    return v;
}

#define XB_TMO      128
#define XB_XCNT(j)  (256  + 64 * (j))
#define XB_XSUB(j)  (1280 + 64 * (j))
#define XB_XGEN(j)  (2304 + 64 * (j))
#define XB_TOP      3328
#define XB_TOPGEN   3392
#define XCD_BAR_WORDS 3456
#define XB_SPIN_CAP (1u << 18)

__device__ __forceinline__ unsigned xb_ld(unsigned* p)              { return __hip_atomic_load(p, __ATOMIC_RELAXED, __HIP_MEMORY_SCOPE_AGENT); }
__device__ __forceinline__ unsigned xb_add(unsigned* p, unsigned v) { return __hip_atomic_fetch_add(p, v, __ATOMIC_RELAXED, __HIP_MEMORY_SCOPE_AGENT); }
__device__ __forceinline__ unsigned xb_xcc_id() { return (unsigned)__builtin_amdgcn_s_getreg((3 << 11) | 20) & 0xFu; }
#define XB_SPIN(cond, bar) do { unsigned _sp = 0; while (cond) { __builtin_amdgcn_s_sleep(1); \
    if ((++_sp & 255u) == 0u) { if (xb_ld(&(bar)[XB_TMO])) break; if (_sp > XB_SPIN_CAP) { atomicAdd(&(bar)[XB_TMO], 1u); break; } } } } while (0)

struct XcdBarrier {
    unsigned* bar; unsigned x;
    volatile LAS unsigned* st;
    int w;
};

__device__ __forceinline__ XcdBarrier xcd_barrier_post(unsigned* bar, volatile LAS unsigned* st) {
    XcdBarrier b; b.bar = bar; b.x = xb_xcc_id(); b.st = st;
    if (threadIdx.x == 0) (void)xb_add(&bar[XB_XCNT(b.x)], 1u);
    return b;
}
__device__ __forceinline__ void xcd_barrier_complete(unsigned* bar, unsigned x, unsigned& nloc, unsigned& nx) {
    const unsigned G = gridDim.x * gridDim.y * gridDim.z;
    unsigned sum, cnt, mine, sp = 0u;
    for (;;) {
        sum = 0u; cnt = 0u; mine = 0u;
#pragma unroll
        for (unsigned j = 0; j < 16; ++j) { const unsigned c = xb_ld(&bar[XB_XCNT(j)]); sum += c; cnt += (c > 0u) ? 1u : 0u; mine = (j == x) ? c : mine; }
        if (sum == G) break;
        __builtin_amdgcn_s_sleep(1);
        if ((++sp & 255u) == 0u) { if (xb_ld(&bar[XB_TMO])) break; if (sp > XB_SPIN_CAP) { atomicAdd(&bar[XB_TMO], 1u); break; } }
    }
    nloc = mine > 0u ? mine : 1u; nx = cnt > 0u ? cnt : 1u;
}

__device__ __forceinline__ void xcd_barrier(const XcdBarrier& b) {
    asm volatile("s_waitcnt vmcnt(0)" ::: "memory");
    __syncthreads();
    if (b.w == 0 && fresh_lane() == 0) {
        unsigned* bar = b.bar;
        __builtin_amdgcn_s_waitcnt(0);
        unsigned nloc = b.st[0], nx = b.st[1];
        if (nloc == 0u) { xcd_barrier_complete(bar, b.x, nloc, nx); b.st[0] = nloc; b.st[1] = nx; }
        const unsigned old = xb_add(&bar[XB_XSUB(b.x)], 1u);
        const unsigned gen = old / nloc;
        if (old + 1u == (gen + 1u) * nloc) {
            __builtin_amdgcn_fence(__ATOMIC_RELEASE, "agent");
            asm volatile("s_waitcnt vmcnt(0)" ::: "memory");
            const unsigned og = xb_add(&bar[XB_TOP], 1u);
            const unsigned tg = og / nx;
            if (og + 1u == (tg + 1u) * nx) xb_add(&bar[XB_TOPGEN], 1u);
            else XB_SPIN(xb_ld(&bar[XB_TOPGEN]) == tg, bar);
            __builtin_amdgcn_fence(__ATOMIC_ACQUIRE, "agent");
            xb_add(&bar[XB_XGEN(b.x)], 1u);
            asm volatile("s_waitcnt vmcnt(0)" ::: "memory");
        } else {
            XB_SPIN(xb_ld(&bar[XB_XGEN(b.x)]) == gen, bar);
            __builtin_amdgcn_fence(__ATOMIC_ACQUIRE, "agent");
            asm volatile("s_waitcnt vmcnt(0)" ::: "memory");
        }
    }
    __syncthreads();
}

#define P0T_DECL(x) const float* x##W = nullptr; const float* x##G = nullptr; bf16* x##T = nullptr; int x##K = 0, x##N = 0, x##k0 = 0, x##n0 = 0, x##ld = 0, x##blk = 0, x##off = 0
__device__ __forceinline__ void p0_load(const float* W, int N, int k0, int n0, int lane, f32x4 (&v)[16]) {
    const int c = lane & 15, rq = lane >> 4;
    int col = n0 + 4 * c; col = col < N - 4 ? col : N - 4;
    const float* p = W + (size_t)(k0 + rq) * N + col;
#pragma unroll
    for (int j = 0; j < 16; ++j) v[j] = __builtin_nontemporal_load((const f32x4*)(p + (size_t)(4 * j) * N));
}
__device__ __forceinline__ void p0_finish(bf16* WT, const float* gain, int N, int k0, int n0, int ldw, int blk, int off, int lane, const f32x4 (&v)[16], LAS float* scr) {
    const int c = lane & 15, rq = lane >> 4, c8 = lane & 7;
    f32x4 g0 = {1.f, 1.f, 1.f, 1.f}, g1 = g0;
    if (gain) { g0 = *(const f32x4*)(gain + k0 + 8 * c8); g1 = *(const f32x4*)(gain + k0 + 8 * c8 + 4); }
#pragma unroll
    for (int j = 0; j < 16; ++j) { LAS float* s = scr + (4 * j + rq) * 65 + 4 * c; s[0] = v[j][0]; s[1] = v[j][1]; s[2] = v[j][2]; s[3] = v[j][3]; }
    asm volatile("s_waitcnt lgkmcnt(0)" ::: "memory");
#pragma unroll
    for (int jj = 0; jj < 8; ++jj) { const int n = (lane >> 3) + 8 * jj; const LAS float* s = scr + (8 * c8) * 65 + n;
        u32x4 o; o.x = pk2(s[0 * 65] * g0[0], s[1 * 65] * g0[1]); o.y = pk2(s[2 * 65] * g0[2], s[3 * 65] * g0[3]); o.z = pk2(s[4 * 65] * g1[0], s[5 * 65] * g1[1]); o.w = pk2(s[6 * 65] * g1[2], s[7 * 65] * g1[3]);
        const int ng = n0 + n;
        if (ng < N) { const int row = (ng >> 7) * blk + (ng & 127) + off; __builtin_nontemporal_store(o, (u32x4*)(WT + (size_t)row * ldw + k0 + 8 * c8)); } }
    asm volatile("s_waitcnt lgkmcnt(0)" ::: "memory");
}

constexpr int ATT_KS_BYTES = 32 * 272, ATT_VS_BYTES = ATT_KS_BYTES + 32 * 320;
static_assert(8 * ATT_VS_BYTES <= LDSCTL_OFF, "attention LDS");
typedef short v4i16_t __attribute__((ext_vector_type(4)));
typedef __bf16 bf16x2_t __attribute__((ext_vector_type(2)));
__device__ __forceinline__ unsigned cvtpk_c(float lo, float hi) { f32x2 v = {lo, hi}; bf16x2_t b = __builtin_convertvector(v, bf16x2_t); return __builtin_bit_cast(unsigned, b); }
__device__ __forceinline__ bf16x8 pack_step(const f32x16& x, int s) { u32x4 p; p.x = cvtpk_c(x[8 * s], x[8 * s + 1]); p.y = cvtpk_c(x[8 * s + 2], x[8 * s + 3]); p.z = cvtpk_c(x[8 * s + 4], x[8 * s + 5]); p.w = cvtpk_c(x[8 * s + 6], x[8 * s + 7]); return __builtin_bit_cast(bf16x8, p); }
__device__ __forceinline__ v4i16_t tr16(const LAS unsigned char* p) { return __builtin_amdgcn_ds_read_tr16_b64_v4i16((LAS v4i16_t*)p); }
__device__ __forceinline__ void att_tile(const LAS unsigned char* kb, const LAS unsigned char* vb, int k0, int lq, int i, int hh, int troff,
                                         const bf16x8 (&qf)[8], f32x16 (&oacc)[4], float& mrun, float& lrun) {
    constexpr float SC = 0.08838834764831845f * 1.4426950408889634f;
    f32x16 sacc, sacc2;
#pragma unroll
    for (int r = 0; r < 16; ++r) { sacc[r] = 0.f; sacc2[r] = 0.f; }
#pragma unroll
    for (int s = 0; s < 8; s += 2) { sacc = __builtin_amdgcn_mfma_f32_32x32x16_bf16(*(const LAS bf16x8*)(kb + i * 272 + 32 * s + 16 * hh), qf[s], sacc, 0, 0, 0);
        sacc2 = __builtin_amdgcn_mfma_f32_32x32x16_bf16(*(const LAS bf16x8*)(kb + i * 272 + 32 * (s + 1) + 16 * hh), qf[s + 1], sacc2, 0, 0, 0); }
#pragma unroll
    for (int r = 0; r < 16; ++r) sacc[r] += sacc2[r];
    float tmax = -1e30f;
    const int dbase = lq - k0 - 4 * hh;
#pragma unroll
    for (int r = 0; r < 16; ++r) { const unsigned dd = (unsigned)(dbase - ((r & 3) + 8 * (r >> 2)));
        const float sv = dd <= 128u ? sacc[r] * SC : -INFINITY; sacc[r] = sv; tmax = fmaxf(tmax, sv); }
    tmax = fmaxf(tmax, __shfl_xor(tmax, 32));
    const float mnew = fmaxf(mrun, tmax);
    const float alpha = __builtin_amdgcn_exp2f(mrun - mnew);
#pragma unroll
    for (int dt = 0; dt < 4; ++dt)
#pragma unroll
        for (int r = 0; r < 16; ++r) oacc[dt][r] *= alpha;
    float psum = 0.f;
#pragma unroll
    for (int r = 0; r < 16; ++r) { const float p = __builtin_amdgcn_exp2f(sacc[r] - mnew); sacc[r] = p; psum += p; }
    psum += __shfl_xor(psum, 32);
    lrun = lrun * alpha + psum; mrun = mnew;
    const bf16x8 pf0 = pack_step(sacc, 0), pf1 = pack_step(sacc, 1);
#pragma unroll
    for (int dt = 0; dt < 4; ++dt) {
        const LAS unsigned char* vp = vb + troff + dt * 64;
        const v4i16_t a0 = tr16(vp), a1 = tr16(vp + 8 * 320), a2 = tr16(vp + 16 * 320), a3 = tr16(vp + 24 * 320);
        const bf16x8 A0 = __builtin_shufflevector(a0, a1, 0, 1, 2, 3, 4, 5, 6, 7), A1 = __builtin_shufflevector(a2, a3, 0, 1, 2, 3, 4, 5, 6, 7);
        oacc[dt] = __builtin_amdgcn_mfma_f32_32x32x16_bf16(A0, pf0, oacc[dt], 0, 0, 0);
        oacc[dt] = __builtin_amdgcn_mfma_f32_32x32x16_bf16(A1, pf1, oacc[dt], 0, 0, 0);
    }
}
__device__ __forceinline__ void attn_wg(const bf16* PROJ, bf16* CONCAT, int wu, LAS unsigned char* L, int tid, int lane, int wave) {
    const int half = wu & 1, bh = (wu >> 1) & 63, blk = 3 - (wu >> 7), h = bh & 15, b = bh >> 4;
    const int rho = 4 * (wave & 3) + 2 * half + (wave >> 2);
    const int i = lane & 31, hh = lane >> 5, l0 = blk * 32;
    const int tq = 16 * (l0 + i) + rho;
    const size_t rowbase = (size_t)b * SEQ;
    bf16x8 qf[8];
    { const bf16* qp = PROJ + (rowbase + tq) * LDP + PJ_Q + h * HD + 8 * hh;
#pragma unroll
      for (int s = 0; s < 8; ++s) qf[s] = *(const bf16x8*)(qp + 16 * s); }
    f32x16 oacc[4];
#pragma unroll
    for (int dt = 0; dt < 4; ++dt)
#pragma unroll
        for (int r = 0; r < 16; ++r) oacc[dt][r] = 0.f;
    float mrun = -1e30f, lrun = 0.f;
    const int g16 = lane >> 4, i16 = lane & 15;
    const int troff = (4 * (g16 >> 1) + (i16 >> 2)) * 320 + (16 * (g16 & 1) + 4 * (i16 & 3)) * 2;
    const bf16* kbase = PROJ + rowbase * LDP + PJ_K + h * HD;
    const bf16* vbase = PROJ + rowbase * LDP + PJ_V + h * HD;
    constexpr int TILE = ATT_VS_BYTES;
    __syncthreads();
    { const int kA = 512 * blk - 128 > 0 ? 512 * blk - 128 : 0, nt = (512 * blk + 511 - kA) / 32 + 1;
      const int row = tid >> 4, ch = tid & 15, lq = tq;
      u32x4 kr, vr;
      { int tok = kA + row; tok = tok < SEQ - 1 ? tok : SEQ - 1; kr = *(const u32x4*)(kbase + (size_t)tok * LDP + 8 * ch); vr = *(const u32x4*)(vbase + (size_t)tok * LDP + 8 * ch); }
      *(LAS u32x4*)(L + row * 272 + 16 * ch) = kr; *(LAS u32x4*)(L + ATT_KS_BYTES + row * 320 + 16 * ch) = vr;
      __syncthreads();
      for (int j = 0; j < nt; ++j) {
          const bool more = j + 1 < nt;
          if (more) { int tok = kA + 32 * (j + 1) + row; tok = tok < SEQ - 1 ? tok : SEQ - 1; kr = *(const u32x4*)(kbase + (size_t)tok * LDP + 8 * ch); vr = *(const u32x4*)(vbase + (size_t)tok * LDP + 8 * ch); }
          const LAS unsigned char* tb = L + (j & 1) * TILE;
          att_tile(tb, tb + ATT_KS_BYTES, kA + 32 * j, lq, i, hh, troff, qf, oacc, mrun, lrun);
          if (more) { LAS unsigned char* nb = L + ((j + 1) & 1) * TILE; *(LAS u32x4*)(nb + row * 272 + 16 * ch) = kr; *(LAS u32x4*)(nb + ATT_KS_BYTES + row * 320 + 16 * ch) = vr; }
          __syncthreads();
      } }
    { const int kB = 4 * l0 - 128 > 0 ? 4 * l0 - 128 : 0, nt = (4 * l0 + 127 - kB) / 32 + 1;
      const int grp = wave >> 2, tg = tid & 255, row = tg >> 3, ch = 2 * (tg & 7), rd = rho & 3, lq = 4 * (l0 + i) + (rho >> 2);
      LAS unsigned char* gb = L + grp * 2 * TILE;
      u32x4 kr0, kr1, vr0, vr1;
      { int tok = ((kB + row) << 2) + rd; tok = tok < SEQ - 1 ? tok : SEQ - 1; const bf16* kp = kbase + (size_t)tok * LDP + 8 * ch; const bf16* vp = vbase + (size_t)tok * LDP + 8 * ch;
        kr0 = *(const u32x4*)kp; kr1 = *(const u32x4*)(kp + 8); vr0 = *(const u32x4*)vp; vr1 = *(const u32x4*)(vp + 8); }
      { LAS u32x4* kd = (LAS u32x4*)(gb + row * 272 + 16 * ch); kd[0] = kr0; kd[1] = kr1; LAS u32x4* vd = (LAS u32x4*)(gb + ATT_KS_BYTES + row * 320 + 16 * ch); vd[0] = vr0; vd[1] = vr1; }
      __syncthreads();
      for (int j = 0; j < nt; ++j) {
          const bool more = j + 1 < nt;
          if (more) { int tok = ((kB + 32 * (j + 1) + row) << 2) + rd; tok = tok < SEQ - 1 ? tok : SEQ - 1; const bf16* kp = kbase + (size_t)tok * LDP + 8 * ch; const bf16* vp = vbase + (size_t)tok * LDP + 8 * ch;
              kr0 = *(const u32x4*)kp; kr1 = *(const u32x4*)(kp + 8); vr0 = *(const u32x4*)vp; vr1 = *(const u32x4*)(vp + 8); }
          const LAS unsigned char* tb = gb + (j & 1) * TILE;
          att_tile(tb, tb + ATT_KS_BYTES, kB + 32 * j, lq, i, hh, troff, qf, oacc, mrun, lrun);
          if (more) { LAS unsigned char* nb = gb + ((j + 1) & 1) * TILE; LAS u32x4* kd = (LAS u32x4*)(nb + row * 272 + 16 * ch); kd[0] = kr0; kd[1] = kr1;
              LAS u32x4* vd = (LAS u32x4*)(nb + ATT_KS_BYTES + row * 320 + 16 * ch); vd[0] = vr0; vd[1] = vr1; }
          __syncthreads();
      } }
    { const int kC = l0 - 128 > 0 ? l0 - 128 : 0, nt = (l0 + 31 - kC) / 32 + 1, lq = l0 + i;
      LAS unsigned char* wb = L + wave * TILE;
      u32x4 kst[8], vst[8];
#define ATT_LOADC(K0) do { _Pragma("unroll") for (int jj_ = 0; jj_ < 8; ++jj_) { int tok_ = (((K0) + 4 * jj_ + g16) << 4) + rho; tok_ = tok_ < SEQ - 1 ? tok_ : SEQ - 1; \
        kst[jj_] = *(const u32x4*)(kbase + (size_t)tok_ * LDP + 8 * i16); vst[jj_] = *(const u32x4*)(vbase + (size_t)tok_ * LDP + 8 * i16); } } while (0)
      for (int j = 0; j < nt; ++j) {
          ATT_LOADC(kC + 32 * j);
#pragma unroll
          for (int jj = 0; jj < 8; ++jj) { *(LAS u32x4*)(wb + (4 * jj + g16) * 272 + i16 * 16) = kst[jj]; *(LAS u32x4*)(wb + ATT_KS_BYTES + (4 * jj + g16) * 320 + i16 * 16) = vst[jj]; }
          att_tile(wb, wb + ATT_KS_BYTES, kC + 32 * j, lq, i, hh, troff, qf, oacc, mrun, lrun);
      }
#undef ATT_LOADC
    }
    const float inv = 1.0f / lrun;
    bf16* op = CONCAT + (rowbase + tq) * LDD + h * HD + 4 * hh;
#pragma unroll
    for (int dt = 0; dt < 4; ++dt)
#pragma unroll
        for (int g = 0; g < 4; ++g) { u32x2 w; w.x = cvtpk_c(oacc[dt][4 * g] * inv, oacc[dt][4 * g + 1] * inv); w.y = cvtpk_c(oacc[dt][4 * g + 2] * inv, oacc[dt][4 * g + 3] * inv);
            *(u32x2*)(op + 32 * dt + 8 * g) = w; }
}

constexpr int DN_NW = 0, DN_QD = 16896, DN_QK = 33792, DN_KDT = 42496, DN_U = 59904, DN_BLK = 76288;
constexpr int DN_GL = DN_QK + 128, DN_LBLK = 61440;
constexpr int CL_KS = 0, CL_QS = 17408, CL_KT = 34816, CL_VT = 53248, CL_AS = 71680, CL_TW = 89088, CL_TU = 98304, CL_TB = 107520, CL_QK = 116736, CL_TT = 125440, CL_A10 = 128000, CL_GC = 130560, CL_CW2 = 131072, CL_END = 131072 + 2 * 6144;
static_assert(CL_END <= LDSCTL_OFF && 2 * 61440 <= LDSCTL_OFF, "DeltaNet LDS maps");
__device__ __forceinline__ int crow16(int reg, int hh) { return (reg & 3) + 8 * (reg >> 2) + 4 * hh; }
__device__ __forceinline__ bf16x8 ld_perm(const LAS unsigned char* p) {
    const v4i16_t lo = *(const LAS v4i16_t*)p, hi = *(const LAS v4i16_t*)(p + 16); return __builtin_shufflevector(lo, hi, 0, 1, 2, 3, 4, 5, 6, 7); }

#define CL_PREFETCH(U_) do { const int n_ = (U_) & 31, bh_ = (U_) >> 5, h_ = bh_ & 15, m0_ = (bh_ >> 4) * SEQ + 64 * n_, tt_ = tid >> 3, cg_ = tid & 7; \
        _Pragma("unroll") for (int seg_ = 0; seg_ < 3; ++seg_) _Pragma("unroll") for (int tap_ = 0; tap_ < 4; ++tap_) { const int dr_ = (64 * n_ + tt_ - 3 + tap_ >= 0) ? tap_ - 3 : 0; \
            const bf16* pr_ = PROJ + (size_t)(m0_ + tt_ + dr_) * LDP + PJ_DQKV + seg_ * 2048 + h_ * HD + 16 * cg_; xr[(seg_ * 4 + tap_) * 2] = *(const u32x4*)pr_; xr[(seg_ * 4 + tap_) * 2 + 1] = *(const u32x4*)(pr_ + 8); } \
        gpre = GLOG[(size_t)(m0_ + lane) * 16 + h_]; bpre = BETA[(size_t)(m0_ + lane) * 16 + h_]; } while (0)
__device__ __forceinline__ void dn_chunk_local(int unit, int nxt_unit, int slot, int& sh0, int& sh1, u32x4 (&xr)[24], float& gpre, float& bpre, const bf16* PROJ, const float* conv_w, const float* GLOG, const float* BETA,
                                               unsigned char* blocks, LAS unsigned char* L, int tid, int lane, int wave) {
    asm volatile("" : "+v"(tid), "+v"(lane), "+s"(wave));
    const int n = unit & 31, bh = unit >> 5, h = bh & 15, b = bh >> 4, hh = lane >> 5;
    unsigned char* blk = blocks + (size_t)unit * DN_BLK;
    LAS float* cws = (LAS float*)(L + CL_CW2 + slot * 6144);
    LAS float* gcs = (LAS float*)(L + CL_GC); LAS float* betas = gcs + 64;
    if ((slot ? sh1 : sh0) != h) {
        __syncthreads();
        for (int e = tid; e < 3 * 4 * 128; e += 512) { const int seg = e >> 9, tap = (e >> 7) & 3, ch = e & 127; cws[e] = conv_w[tap * 6144 + seg * 2048 + h * HD + ch]; }
        if (slot) sh1 = h; else sh0 = h;
        __syncthreads();
    }
    float gcv = gpre;
#pragma unroll
    for (int o = 1; o < 64; o <<= 1) { const float t = __shfl_up(gcv, o); if (lane >= o) gcv += t; }
    const float gc_last = __shfl(gcv, 63);
    if (wave == 0) { gcs[lane] = gcv; betas[lane] = bpre; }
    { const int tt = tid >> 3, cg = tid & 7, t = 64 * n + tt;
      const float egc = __expf(__shfl(gcv, tt));
#pragma unroll
      for (int seg = 0; seg < 3; ++seg) {
          float a[16];
#pragma unroll
          for (int e = 0; e < 16; ++e) a[e] = 0.f;
#pragma unroll
          for (int tap = 0; tap < 4; ++tap) { if (t - 3 + tap >= 0) {
              const u32x4 x0 = xr[(seg * 4 + tap) * 2], x1 = xr[(seg * 4 + tap) * 2 + 1];
              const LAS f32x4* w4 = (const LAS f32x4*)(cws + (seg * 4 + tap) * 128 + 16 * cg);
              const f32x4 w0 = w4[0], w1 = w4[1], w2 = w4[2], w3 = w4[3];
              a[0] += w0[0] * bf_lo(x0.x); a[1] += w0[1] * bf_hi(x0.x); a[2] += w0[2] * bf_lo(x0.y); a[3] += w0[3] * bf_hi(x0.y);
              a[4] += w1[0] * bf_lo(x0.z); a[5] += w1[1] * bf_hi(x0.z); a[6] += w1[2] * bf_lo(x0.w); a[7] += w1[3] * bf_hi(x0.w);
              a[8] += w2[0] * bf_lo(x1.x); a[9] += w2[1] * bf_hi(x1.x); a[10] += w2[2] * bf_lo(x1.y); a[11] += w2[3] * bf_hi(x1.y);
              a[12] += w3[0] * bf_lo(x1.z); a[13] += w3[1] * bf_hi(x1.z); a[14] += w3[2] * bf_lo(x1.w); a[15] += w3[3] * bf_hi(x1.w); } }
          float ss = 0.f;
#pragma unroll
          for (int e = 0; e < 16; ++e) { a[e] = pg8::silu_f(a[e]); ss += a[e] * a[e]; }
          if (seg < 2) { ss += __shfl_xor(ss, 1); ss += __shfl_xor(ss, 2); ss += __shfl_xor(ss, 4);
              const float rn = rsqrtf(ss + EPS) * (seg == 0 ? 0.08838834764831845f : 1.0f);
#pragma unroll
              for (int e = 0; e < 16; ++e) a[e] *= rn; }
          if (seg == 0) {
              u32x4 p0, p1; p0.x = cvtpk_c(a[0], a[1]); p0.y = cvtpk_c(a[2], a[3]); p0.z = cvtpk_c(a[4], a[5]); p0.w = cvtpk_c(a[6], a[7]);
              p1.x = cvtpk_c(a[8], a[9]); p1.y = cvtpk_c(a[10], a[11]); p1.z = cvtpk_c(a[12], a[13]); p1.w = cvtpk_c(a[14], a[15]);
              LAS u32x4* qd = (LAS u32x4*)(L + CL_QS + tt * 272 + 32 * cg); qd[0] = p0; qd[1] = p1;
              u32x2* g = (u32x2*)(blk + DN_QD + tt * 264 + 32 * cg);
              u32x2 o; o.x = cvtpk_c(a[0] * egc, a[1] * egc); o.y = cvtpk_c(a[2] * egc, a[3] * egc); g[0] = o;
              o.x = cvtpk_c(a[4] * egc, a[5] * egc); o.y = cvtpk_c(a[6] * egc, a[7] * egc); g[1] = o;
              o.x = cvtpk_c(a[8] * egc, a[9] * egc); o.y = cvtpk_c(a[10] * egc, a[11] * egc); g[2] = o;
              o.x = cvtpk_c(a[12] * egc, a[13] * egc); o.y = cvtpk_c(a[14] * egc, a[15] * egc); g[3] = o;
          } else {
              if (seg == 1) { u32x4 p0, p1; p0.x = cvtpk_c(a[0], a[1]); p0.y = cvtpk_c(a[2], a[3]); p0.z = cvtpk_c(a[4], a[5]); p0.w = cvtpk_c(a[6], a[7]);
                  p1.x = cvtpk_c(a[8], a[9]); p1.y = cvtpk_c(a[10], a[11]); p1.z = cvtpk_c(a[12], a[13]); p1.w = cvtpk_c(a[14], a[15]);
                  LAS u32x4* kd = (LAS u32x4*)(L + CL_KS + tt * 272 + 32 * cg); kd[0] = p0; kd[1] = p1; }
              LAS bf16* tp = (LAS bf16*)(L + (seg == 1 ? CL_KT : CL_VT)) + (16 * cg) * 72 + ((tt + 8 * cg) & 63);
#pragma unroll
              for (int e = 0; e < 16; ++e) tp[e * 72] = (bf16)(cvtpk_c(a[e], 0.f) & 0xffffu);
          }
      } }
    CL_PREFETCH(nxt_unit);
    __syncthreads();
    { const int mat = wave >> 2, ti = (wave >> 1) & 1, tj = wave & 1, r = lane & 31;
      f32x16 acc;
#pragma unroll
      for (int i = 0; i < 16; ++i) acc[i] = 0.f;
      if (!(ti == 0 && tj == 1)) {
          const LAS unsigned char* ap = L + (mat == 0 ? CL_KS : CL_QS) + (32 * ti + r) * 272 + 16 * hh;
          const LAS unsigned char* bp = L + CL_KS + (32 * tj + r) * 272 + 16 * hh;
#pragma unroll
          for (int s = 0; s < 8; ++s) acc = __builtin_amdgcn_mfma_f32_32x32x16_bf16(*(const LAS bf16x8*)(ap + 32 * s), *(const LAS bf16x8*)(bp + 32 * s), acc, 0, 0, 0);
      }
      const int j = 32 * tj + r; const float gcj = gcs[j];
#pragma unroll
      for (int reg = 0; reg < 16; ++reg) { const int i = 32 * ti + crow16(reg, hh);
          const float e = (i >= j) ? __expf(gcs[i] - gcj) : 0.f;
          if (mat == 0) { const float val = (i > j) ? betas[i] * acc[reg] * e : 0.f;
              ((LAS float*)(L + CL_AS))[i * 68 + j] = val;
              if (ti == 1 && tj == 0) ((LAS bf16*)(L + CL_A10))[(i - 32) * 40 + j] = (bf16)(cvtpk_c(val, 0.f) & 0xffffu); }
          else ((LAS bf16*)(L + CL_QK))[i * 68 + j] = (bf16)(cvtpk_c(acc[reg] * e, 0.f) & 0xffffu); }
    }
    __syncthreads();
    if (wave == 0) {
        const int half = hh, c = lane & 31, cf = 32 * half + c;
        const LAS float* Ab = (const LAS float*)(L + CL_AS) + (32 * half) * 68 + 32 * half;
        float t[32];
        f32x4 cur[8], nxt[8];
#pragma unroll
        for (int q = 0; q < 8; ++q) { cur[q] = (f32x4){0.f, 0.f, 0.f, 0.f}; nxt[q] = cur[q]; }
#pragma unroll
        for (int i = 0; i < 32; ++i) {
            if (i + 1 < 32) {
#pragma unroll
                for (int j4 = 0; j4 < (i + 4) / 4; ++j4) nxt[j4] = *(const LAS f32x4*)(Ab + (i + 1) * 68 + 4 * j4); }
            float s0 = (i == c) ? 1.f : 0.f, s1 = 0.f;
#pragma unroll
            for (int j4 = 0; j4 < (i + 3) / 4; ++j4) {
#pragma unroll
                for (int e = 0; e < 4; ++e) { const int jj = 4 * j4 + e; if (jj < i) { if (jj & 1) s1 -= cur[j4][e] * t[jj]; else s0 -= cur[j4][e] * t[jj]; } } }
            t[i] = s0 + s1;
#pragma unroll
            for (int q = 0; q < 8; ++q) cur[q] = nxt[q];
            asm volatile("" : "+v"(t[i]) :: "memory");
        }
        const float csu = betas[cf], csw = csu * __expf(gcs[cf]);
        LAS bf16* Tw = (LAS bf16*)(L + CL_TW); LAS bf16* Tu = (LAS bf16*)(L + CL_TU); LAS bf16* Tb = (LAS bf16*)(L + CL_TB);
#pragma unroll
        for (int i = 0; i < 32; ++i) { const int rf = 32 * half + i;
            Tw[rf * 72 + cf] = (bf16)(cvtpk_c(t[i] * csw, 0.f) & 0xffffu); Tu[rf * 72 + cf] = (bf16)(cvtpk_c(t[i] * csu, 0.f) & 0xffffu);
            if (half == 1) { Tb[rf * 72 + cf] = (bf16)(cvtpk_c(t[i], 0.f) & 0xffffu); Tw[i * 72 + cf] = 0; Tu[i * 72 + cf] = 0; } }
        if (half == 0) { LAS u32x4* tt4 = (LAS u32x4*)(L + CL_TT + c * 80);
#pragma unroll
            for (int q = 0; q < 4; ++q) { u32x4 w; w.x = cvtpk_c(t[8 * q], t[8 * q + 1]); w.y = cvtpk_c(t[8 * q + 2], t[8 * q + 3]); w.z = cvtpk_c(t[8 * q + 4], t[8 * q + 5]); w.w = cvtpk_c(t[8 * q + 6], t[8 * q + 7]); tt4[q] = w; } }
        f32x16 xacc, tacc;
#pragma unroll
        for (int i = 0; i < 16; ++i) { xacc[i] = 0.f; tacc[i] = 0.f; }
#pragma unroll
        for (int s = 0; s < 2; ++s) xacc = __builtin_amdgcn_mfma_f32_32x32x16_bf16(*(const LAS bf16x8*)(L + CL_A10 + c * 80 + 32 * s + 16 * hh), *(const LAS bf16x8*)(L + CL_TT + c * 80 + 32 * s + 16 * hh), xacc, 0, 0, 0);
#pragma unroll
        for (int s = 0; s < 2; ++s) tacc = __builtin_amdgcn_mfma_f32_32x32x16_bf16(ld_perm(L + CL_TB + (32 + c) * 144 + (32 + 16 * s + 4 * hh) * 2), pack_step(xacc, s), tacc, 0, 0, 0);
        const float c0u = betas[c], c0w = c0u * __expf(gcs[c]);
#pragma unroll
        for (int reg = 0; reg < 16; ++reg) { const int i = 32 + crow16(reg, hh); const float v = -tacc[reg];
            Tw[i * 72 + c] = (bf16)(cvtpk_c(v * c0w, 0.f) & 0xffffu); Tu[i * 72 + c] = (bf16)(cvtpk_c(v * c0u, 0.f) & 0xffffu); }
    } else {
        const int t7 = tid - 64;
        for (int e = t7; e < 8704 / 8; e += 448) { u32x2 v = *(const LAS u32x2*)(L + CL_QK + 8 * e); if (e == 16) v.x = __float_as_uint(__expf(gc_last)); *(u32x2*)(blk + DN_QK + 8 * e) = v; }
        for (int e = t7; e < 128 * 8; e += 448) { const int dk = e >> 3, c8 = e & 7;
            const u32x4 kk = *(const LAS u32x4*)(L + CL_KT + dk * 144 + 16 * ((c8 + (dk >> 4)) & 7));
            const LAS float* gp = gcs + 8 * c8; float kd[8];
#pragma unroll
            for (int q = 0; q < 8; ++q) kd[q] = __expf(gc_last - gp[q]);
            u32x2 o0, o1; o0.x = cvtpk_c(bf_lo(kk.x) * kd[0], bf_hi(kk.x) * kd[1]); o0.y = cvtpk_c(bf_lo(kk.y) * kd[2], bf_hi(kk.y) * kd[3]);
            o1.x = cvtpk_c(bf_lo(kk.z) * kd[4], bf_hi(kk.z) * kd[5]); o1.y = cvtpk_c(bf_lo(kk.w) * kd[6], bf_hi(kk.w) * kd[7]);
            u32x2* g = (u32x2*)(blk + DN_KDT + dk * 136 + 16 * c8); g[0] = o0; g[1] = o1; }
    }
    __syncthreads();
    { const int r = lane & 31;
      { const int dkt = wave >> 1, it = wave & 1, dk = 32 * dkt + r;
        f32x16 acc;
#pragma unroll
        for (int i = 0; i < 16; ++i) acc[i] = 0.f;
#pragma unroll
        for (int s = 0; s < 4; ++s) acc = __builtin_amdgcn_mfma_f32_32x32x16_bf16(*(const LAS bf16x8*)(L + CL_KT + dk * 144 + 16 * ((2 * s + hh + (dk >> 4)) & 7)),
                                                                                  *(const LAS bf16x8*)(L + CL_TW + (32 * it + r) * 144 + 32 * s + 16 * hh), acc, 0, 0, 0);
        LAS unsigned char* wp = L + CL_KS + (32 * it + r) * 264 + (32 * dkt + 4 * hh) * 2;
#pragma unroll
        for (int g = 0; g < 4; ++g) { u32x2 w; w.x = cvtpk_c(-acc[4 * g], -acc[4 * g + 1]); w.y = cvtpk_c(-acc[4 * g + 2], -acc[4 * g + 3]); *(LAS u32x2*)(wp + 16 * g) = w; } }
      { const int it = wave >> 2, dvt = wave & 3, dv = 32 * dvt + r;
        f32x16 acc;
#pragma unroll
        for (int i = 0; i < 16; ++i) acc[i] = 0.f;
#pragma unroll
        for (int s = 0; s < 4; ++s) acc = __builtin_amdgcn_mfma_f32_32x32x16_bf16(*(const LAS bf16x8*)(L + CL_TU + (32 * it + r) * 144 + 32 * s + 16 * hh),
                                                                                  *(const LAS bf16x8*)(L + CL_VT + dv * 144 + 16 * ((2 * s + hh + (dv >> 4)) & 7)), acc, 0, 0, 0);
        u32x4 w0, w1; w0.x = cvtpk_c(acc[0], acc[1]); w0.y = cvtpk_c(acc[2], acc[3]); w0.z = cvtpk_c(acc[4], acc[5]); w0.w = cvtpk_c(acc[6], acc[7]);
        w1.x = cvtpk_c(acc[8], acc[9]); w1.y = cvtpk_c(acc[10], acc[11]); w1.z = cvtpk_c(acc[12], acc[13]); w1.w = cvtpk_c(acc[14], acc[15]);
        u32x4* up = (u32x4*)(blk + DN_U + ((dvt * 2 + it) * 64 + lane) * 32); up[0] = w0; up[1] = w1; } }
    __syncthreads();
    for (int e = tid; e < 16896 / 16; e += 512) *(u32x4*)(blk + DN_NW + 16 * e) = *(const LAS u32x4*)(L + CL_KS + 16 * e);
    __syncthreads();
}

__device__ __forceinline__ void dn_gate_rows(int bh, const float* ORAW, const bf16* PROJ, const float* dn_norm, bf16* CONCAT, int lane, int wave) {
    const int h = bh & 15, b = bh >> 4, sub = lane >> 4, c = 8 * (lane & 15);
    const f32x4 g0 = *(const f32x4*)(dn_norm + c), g1 = *(const f32x4*)(dn_norm + c + 4);
    for (int t0 = wave * 256; t0 < wave * 256 + 256; t0 += 16) {
        f32x4 o0[4], o1[4]; u32x4 zz[4];
#pragma unroll
        for (int u = 0; u < 4; ++u) { const size_t m = (size_t)b * SEQ + t0 + 4 * u + sub; const float* op = ORAW + m * 2048 + h * HD + c;
            o0[u] = *(const f32x4*)op; o1[u] = *(const f32x4*)(op + 4); zz[u] = *(const u32x4*)(PROJ + m * LDP + PJ_DZ + h * HD + c); }
#pragma unroll
        for (int u = 0; u < 4; ++u) { const size_t m = (size_t)b * SEQ + t0 + 4 * u + sub;
            float ss = (o0[u][0] * o0[u][0] + o0[u][1] * o0[u][1]) + (o0[u][2] * o0[u][2] + o0[u][3] * o0[u][3]) + (o1[u][0] * o1[u][0] + o1[u][1] * o1[u][1]) + (o1[u][2] * o1[u][2] + o1[u][3] * o1[u][3]);
            ss += __shfl_xor(ss, 1); ss += __shfl_xor(ss, 2); ss += __shfl_xor(ss, 4); ss += __shfl_xor(ss, 8);
            const float r = rsqrtf(ss * (1.0f / HD) + EPS);
            u32x4 w;
            w.x = pk2(o0[u][0] * r * g0[0] * pg8::silu_f(bf_lo(zz[u].x)), o0[u][1] * r * g0[1] * pg8::silu_f(bf_hi(zz[u].x)));
            w.y = pk2(o0[u][2] * r * g0[2] * pg8::silu_f(bf_lo(zz[u].y)), o0[u][3] * r * g0[3] * pg8::silu_f(bf_hi(zz[u].y)));
            w.z = pk2(o1[u][0] * r * g1[0] * pg8::silu_f(bf_lo(zz[u].z)), o1[u][1] * r * g1[1] * pg8::silu_f(bf_hi(zz[u].z)));
            w.w = pk2(o1[u][2] * r * g1[2] * pg8::silu_f(bf_lo(zz[u].w)), o1[u][3] * r * g1[3] * pg8::silu_f(bf_hi(zz[u].w)));
            *(u32x4*)(CONCAT + m * LDD + 2048 + h * HD + c) = w; }
    }
}
__device__ __forceinline__ void dn_scan(int bh, const unsigned char* blocks, float* ORAW, LAS unsigned char* L, int tid, int lane, int wave) {
    const int h = bh & 15, b = bh >> 4;
    const unsigned char* src = blocks + (size_t)(bh * 32) * DN_BLK;
    constexpr int NLD = DN_LBLK / 16 / 256;
    static_assert(DN_LBLK % 4096 == 0 && DN_LBLK >= DN_U && DN_LBLK <= DN_BLK, "block image");
    if (wave >= 4) {
        const int e0 = tid - 256;
        u32x4 ra[NLD], rb[NLD], rc[NLD];
#define DN_LD(R, BLKI) do { const unsigned char* sp_ = src + (size_t)((BLKI) < 31 ? (BLKI) : 31) * DN_BLK; _Pragma("unroll") for (int j_ = 0; j_ < NLD; ++j_) R[j_] = *(const u32x4*)(sp_ + 16 * e0 + 4096 * j_); } while (0)
#define DN_ST(R, P) do { LAS unsigned char* dp_ = L + (P) * DN_LBLK; _Pragma("unroll") for (int j_ = 0; j_ < NLD; ++j_) *(LAS u32x4*)(dp_ + 16 * e0 + 4096 * j_) = R[j_]; } while (0)
        DN_LD(ra, 0); DN_LD(rb, 1); DN_LD(rc, 2);
        DN_ST(ra, 0); DN_LD(ra, 3);
#define DN_STEP(N, R) do { __syncthreads(); DN_ST(R, ((N) + 1) & 1); DN_LD(R, (N) + 4); } while (0)
        for (int n = 0; n < 30; n += 3) { DN_STEP(n, rb); DN_STEP(n + 1, rc); DN_STEP(n + 2, ra); }
        DN_STEP(30, rb); DN_STEP(31, rc);
        __syncthreads();
#undef DN_STEP
#undef DN_ST
#undef DN_LD
        return;
    }
    int r = lane & 31, hh = lane >> 5;
    f32x16 Sacc[4];
#pragma unroll
    for (int t = 0; t < 4; ++t)
#pragma unroll
        for (int i = 0; i < 16; ++i) Sacc[t][i] = 0.f;
    float* op = ORAW + (size_t)(b * SEQ) * 2048 + h * HD + 32 * wave + r;
    const unsigned char* ugp = src + DN_U + ((wave * 2) * 64 + lane) * 32;
    u32x4 ua0, ua1, ua2, ua3, ub0, ub1, ub2, ub3, uc0, uc1, uc2, uc3;
#define DN_ULD(A0, A1, A2, A3, BLKI) do { const u32x4* p_ = (const u32x4*)(ugp + (size_t)((BLKI) < 31 ? (BLKI) : 31) * DN_BLK); A0 = p_[0]; A1 = p_[1]; A2 = p_[128]; A3 = p_[129]; } while (0)
    DN_ULD(ua0, ua1, ua2, ua3, 0); DN_ULD(ub0, ub1, ub2, ub3, 1); DN_ULD(uc0, uc1, uc2, uc3, 2);
    for (int n = 0; n < 32; ++n) {
        __syncthreads();
        const LAS unsigned char* B = L + (n & 1) * DN_LBLK;
        const float gl = *(const LAS float*)(B + DN_GL);
        f32x16 x0, x1;
        { const u32x4 a0 = ua0, a1 = ua1, b0 = ua2, b1 = ua3;
          x0[0] = bf_lo(a0.x); x0[1] = bf_hi(a0.x); x0[2] = bf_lo(a0.y); x0[3] = bf_hi(a0.y); x0[4] = bf_lo(a0.z); x0[5] = bf_hi(a0.z); x0[6] = bf_lo(a0.w); x0[7] = bf_hi(a0.w);
          x0[8] = bf_lo(a1.x); x0[9] = bf_hi(a1.x); x0[10] = bf_lo(a1.y); x0[11] = bf_hi(a1.y); x0[12] = bf_lo(a1.z); x0[13] = bf_hi(a1.z); x0[14] = bf_lo(a1.w); x0[15] = bf_hi(a1.w);
          x1[0] = bf_lo(b0.x); x1[1] = bf_hi(b0.x); x1[2] = bf_lo(b0.y); x1[3] = bf_hi(b0.y); x1[4] = bf_lo(b0.z); x1[5] = bf_hi(b0.z); x1[6] = bf_lo(b0.w); x1[7] = bf_hi(b0.w);
          x1[8] = bf_lo(b1.x); x1[9] = bf_hi(b1.x); x1[10] = bf_lo(b1.y); x1[11] = bf_hi(b1.y); x1[12] = bf_lo(b1.z); x1[13] = bf_hi(b1.z); x1[14] = bf_lo(b1.w); x1[15] = bf_hi(b1.w); }
        ua0 = ub0; ua1 = ub1; ua2 = ub2; ua3 = ub3; ub0 = uc0; ub1 = uc1; ub2 = uc2; ub3 = uc3; DN_ULD(uc0, uc1, uc2, uc3, n + 3);
#pragma unroll
        for (int t = 0; t < 4; ++t)
#pragma unroll
            for (int s = 0; s < 2; ++s) { const bf16x8 sb = pack_step(Sacc[t], s); const int co = (32 * t + 16 * s + 4 * hh) * 2;
                x0 = __builtin_amdgcn_mfma_f32_32x32x16_bf16(ld_perm(B + DN_NW + r * 264 + co), sb, x0, 0, 0, 0);
                x1 = __builtin_amdgcn_mfma_f32_32x32x16_bf16(ld_perm(B + DN_NW + (32 + r) * 264 + co), sb, x1, 0, 0, 0); }
        const bf16x8 v00 = pack_step(x0, 0), v01 = pack_step(x0, 1), v10 = pack_step(x1, 0), v11 = pack_step(x1, 1);
        f32x16 o0, o1;
#pragma unroll
        for (int i = 0; i < 16; ++i) { o0[i] = 0.f; o1[i] = 0.f; }
#pragma unroll
        for (int t = 0; t < 4; ++t)
#pragma unroll
            for (int s = 0; s < 2; ++s) { const bf16x8 sb = pack_step(Sacc[t], s); const int co = (32 * t + 16 * s + 4 * hh) * 2;
                o0 = __builtin_amdgcn_mfma_f32_32x32x16_bf16(ld_perm(B + DN_QD + r * 264 + co), sb, o0, 0, 0, 0);
                o1 = __builtin_amdgcn_mfma_f32_32x32x16_bf16(ld_perm(B + DN_QD + (32 + r) * 264 + co), sb, o1, 0, 0, 0); }
        o0 = __builtin_amdgcn_mfma_f32_32x32x16_bf16(ld_perm(B + DN_QK + r * 136 + (4 * hh) * 2), v00, o0, 0, 0, 0);
        o0 = __builtin_amdgcn_mfma_f32_32x32x16_bf16(ld_perm(B + DN_QK + r * 136 + (16 + 4 * hh) * 2), v01, o0, 0, 0, 0);
        o1 = __builtin_amdgcn_mfma_f32_32x32x16_bf16(ld_perm(B + DN_QK + (32 + r) * 136 + (4 * hh) * 2), v00, o1, 0, 0, 0);
        o1 = __builtin_amdgcn_mfma_f32_32x32x16_bf16(ld_perm(B + DN_QK + (32 + r) * 136 + (16 + 4 * hh) * 2), v01, o1, 0, 0, 0);
        o1 = __builtin_amdgcn_mfma_f32_32x32x16_bf16(ld_perm(B + DN_QK + (32 + r) * 136 + (32 + 4 * hh) * 2), v10, o1, 0, 0, 0);
        o1 = __builtin_amdgcn_mfma_f32_32x32x16_bf16(ld_perm(B + DN_QK + (32 + r) * 136 + (48 + 4 * hh) * 2), v11, o1, 0, 0, 0);
#pragma unroll
        for (int reg = 0; reg < 16; ++reg) { const int i = crow16(reg, hh); op[(size_t)i * 2048] = o0[reg]; op[(size_t)(32 + i) * 2048] = o1[reg]; }
#pragma unroll
        for (int t = 0; t < 4; ++t) {
#pragma unroll
            for (int i = 0; i < 16; ++i) Sacc[t][i] *= gl;
            const LAS unsigned char* kp = B + DN_KDT + (32 * t + r) * 136 + (4 * hh) * 2;
            Sacc[t] = __builtin_amdgcn_mfma_f32_32x32x16_bf16(ld_perm(kp), v00, Sacc[t], 0, 0, 0);
            Sacc[t] = __builtin_amdgcn_mfma_f32_32x32x16_bf16(ld_perm(kp + 32), v01, Sacc[t], 0, 0, 0);
            Sacc[t] = __builtin_amdgcn_mfma_f32_32x32x16_bf16(ld_perm(kp + 64), v10, Sacc[t], 0, 0, 0);
            Sacc[t] = __builtin_amdgcn_mfma_f32_32x32x16_bf16(ld_perm(kp + 96), v11, Sacc[t], 0, 0, 0); }
        op += (size_t)64 * 2048;
    }
#undef DN_ULD
    __syncthreads();
}

struct Args { const float* in[17]; float* out; unsigned char* ws; int ph_lo, ph_hi; };
constexpr int NPH = 11;

__global__ void __launch_bounds__(NWAVES * 64, 2) fwd(Args args) {
    extern __shared__ __attribute__((aligned(16))) unsigned char lds[];
    LAS unsigned char* L = (LAS unsigned char*)lds;
    volatile LAS unsigned* MISC = (volatile LAS unsigned*)(L + MISC_OFF);
    const int wave = __builtin_amdgcn_readfirstlane((int)threadIdx.x >> 6);
    int lane = fresh_lane(), tid = wave * 64 + lane;
#define REFRESH_IDS() do { lane = fresh_lane(); tid = wave * 64 + lane; } while (0)
    const int G = gridDim.x; const int bx = blockIdx.x; const int vcu = (G % 8 == 0) ? (bx % 8) * (G / 8) + bx / 8 : bx;
    const int gw = vcu * NWAVES + wave, NGW = G * NWAVES;
    unsigned char* ws = args.ws;
    unsigned* ctl = (unsigned*)(ws + WS_CTL);
    const float* x = args.in[0];
    float* out = args.out;
    unsigned long long* ssq = (unsigned long long*)(ws + WS_SSQ);
    float* BETA = (float*)(ws + WS_BETA); float* GLOG = (float*)(ws + WS_G);
    bf16* Wgu1 = (bf16*)(ws + WS_WGU1); bf16* Wd1 = (bf16*)(ws + WS_WD1); bf16* Win = (bf16*)(ws + WS_WIN); bf16* Wout = (bf16*)(ws + WS_WOUT);
    bf16* Wgu2 = (bf16*)(ws + WS_WGU2); bf16* Wd2 = (bf16*)(ws + WS_WD2);
    bf16* XB = (bf16*)(ws + WS_XB); bf16* ACT = (bf16*)(ws + WS_ACT); bf16* PROJ = (bf16*)(ws + WS_PROJ); bf16* CONCAT = (bf16*)(ws + WS_CONCAT);
    unsigned char* DNB = ws + WS_ACT; float* ORAW = (float*)(ws + WS_ORAW);

    for (int u = tid; u < (LDS_BYTES - LDSCTL_OFF) / 4; u += NWAVES * 64) ((LAS unsigned*)(L + LDSCTL_OFF))[u] = 0u;
    __syncthreads();
    XcdBarrier bar; bar.bar = ctl + CW_BAR; bar.x = 0; bar.st = nullptr; bar.w = wave;
#if ONE_LAUNCH
    bar = xcd_barrier_post(ctl + CW_BAR, MISC + 8); bar.w = wave;
#define GRID_BAR() xcd_barrier(bar)
#else
#define GRID_BAR() do { } while (0)
#endif
    const int lo = args.ph_lo, hi = args.ph_hi;
#define IN(k) (lo <= (k) && (k) < hi)
#define BOTH(k) (IN(k) && IN((k) + 1))

    constexpr int T_GU = (D / 64) * (FF / 64), T_DN = (FF / 64) * (D / 64), NT_IN = (NPROJ + 63) / 64, T_IN = (D / 64) * NT_IN, T_OUT = (D / 64) * (D / 64);
    constexpr int NITEMS = 4 * T_GU + 2 * T_DN + T_IN + T_OUT, NI0 = 2 * T_GU + T_DN + T_IN, NCB = (NITEMS - NI0) / 64;
    static_assert((NITEMS - NI0) % 64 == 0, "deferred conversion tiles come in whole batches");
#define P0T_SET(x, pw_, pg_, pt_, pk_, pn_, pkk_, pnn_, pld_, pb_, po_) do { x##W = (pw_); x##G = (pg_); x##T = (pt_); x##K = (pk_); x##N = (pn_); x##k0 = (pkk_); x##n0 = (pnn_); x##ld = (pld_); x##blk = (pb_); x##off = (po_); } while (0)
#define P0T_RESOLVE(x, item) do { int r_ = (item); \
            if (r_ < 2 * T_GU) { const int wh_ = r_ / T_GU; r_ -= wh_ * T_GU; P0T_SET(x, args.in[2 + wh_], args.in[1], Wgu1, D, FF, 64 * (r_ / (FF / 64)), 64 * (r_ % (FF / 64)), LDD, 256, 128 * wh_); break; } r_ -= 2 * T_GU; \
            if (r_ < T_DN) { P0T_SET(x, args.in[4], nullptr, Wd1, FF, D, 64 * (r_ / (D / 64)), 64 * (r_ % (D / 64)), LDF, 128, 0); break; } r_ -= T_DN; \
            if (r_ < T_IN) { P0T_SET(x, args.in[6], args.in[5], Win, D, NPROJ, 64 * (r_ / NT_IN), 64 * (r_ % NT_IN), LDD, 128, 0); break; } r_ -= T_IN; \
            if (r_ < T_OUT) { P0T_SET(x, args.in[11], nullptr, Wout, D, D, 64 * (r_ / (D / 64)), 64 * (r_ % (D / 64)), LDD, 128, 0); break; } r_ -= T_OUT; \
            if (r_ < 2 * T_GU) { const int wh_ = r_ / T_GU; r_ -= wh_ * T_GU; P0T_SET(x, args.in[13 + wh_], args.in[12], Wgu2, D, FF, 64 * (r_ / (FF / 64)), 64 * (r_ % (FF / 64)), LDD, 256, 128 * wh_); break; } r_ -= 2 * T_GU; \
            P0T_SET(x, args.in[15], nullptr, Wd2, FF, D, 64 * (r_ / (D / 64)), 64 * (r_ % (D / 64)), LDF, 128, 0); } while (0)
#define P0_RUN(first, end, stride) do { if ((first) < (end)) { \
            f32x4 va[16], vb[16]; P0T_DECL(a); P0T_DECL(b); \
            P0T_RESOLVE(a, (first)); p0_load(aW, aN, ak0, an0, lane, va); \
            for (int it = (first); it < (end); it += 2 * (stride)) {             \
                const bool hb = it + (stride) < (end); if (hb) { P0T_RESOLVE(b, it + (stride)); p0_load(bW, bN, bk0, bn0, lane, vb); } \
                p0_finish(aT, aG, aN, ak0, an0, ald, ablk, aoff, lane, va, scr); \
                if (!hb) break; \
                const bool ha = it + 2 * (stride) < (end); if (ha) { P0T_RESOLVE(a, it + 2 * (stride)); p0_load(aW, aN, ak0, an0, lane, va); } \
                p0_finish(bT, bG, bN, bk0, bn0, bld, bblk, boff, lane, vb, scr); \
            } } } while (0)
    if (IN(0)) {
        REFRESH_IDS();
        LAS float* scr = (LAS float*)(L + wave * (64 * 65 * 4));
        P0_RUN(gw, NI0, NGW);
        for (int row = gw; row < M; row += NGW) {
            const f32x4* xr = (const f32x4*)(x + (size_t)row * D) + lane; float s = 0.f;
#pragma unroll
            for (int j = 0; j < 16; ++j) { const f32x4 v = xr[64 * j]; s += (v[0] * v[0] + v[1] * v[1]) + (v[2] * v[2] + v[3] * v[3]);
                u32x2 o; o.x = pk2(v[0], v[1]); o.y = pk2(v[2], v[3]); *(u32x2*)(XB + (size_t)row * LDD + 4 * lane + 256 * j) = o; }
            s = wave_sum(s);
            if (lane == 0) ssq[row] = (unsigned long long)(s * FIXS);
        }
        if (BOTH(0)) GRID_BAR();
    }

    if (IN(1)) {
        REFRESH_IDS();
        pg8::Gemm g{XB, Wgu1, M, 2 * FF, D, LDD, LDD}; pg8::StaticOrder S; S.init(M, 2 * FF, G, bx);
        pg8::EpiGateUp E{ACT, ssq};
        pg8::gemm_phase<pg8::EpiGateUp, pg8::StaticOrder, true, true>(L, g, S, E, wave);
        if (BOTH(1)) GRID_BAR();
    }
    if (IN(2)) {
        REFRESH_IDS();
#if DEFER_AT == 2
        { LAS float* scr = (LAS float*)(L + wave * (64 * 65 * 4)); P0_RUN(NI0 + gw, NITEMS, NGW); __syncthreads(); REFRESH_IDS(); }
#endif
        pg8::Gemm g{ACT, Wd1, M, D, FF, LDF, LDF}; pg8::StaticOrder S; S.init(M, D, G, bx);
        pg8::EpiResid<true> E{x, out, XB, ssq + M, 0.5f};
        pg8::gemm_phase<pg8::EpiResid<true>, pg8::StaticOrder, true, true>(L, g, S, E, wave);
        if (BOTH(2)) GRID_BAR();
    }
    if (IN(3)) {
        REFRESH_IDS();
        {
            for (int rt = bx; rt < M / 32; rt += G) {
                const int r = lane & 31, hh = lane >> 5;
                const bf16* ap = XB + (size_t)(32 * rt + r) * LDD + wave * 512 + 8 * hh;
                const bf16* bp = Win + (size_t)(NPROJ_MAIN + r) * LDD + wave * 512 + 8 * hh;
                f32x16 acc; for (int i = 0; i < 16; ++i) acc[i] = 0.f;
#pragma unroll 8
                for (int kk = 0; kk < 32; ++kk) { const bf16x8 a = *(const bf16x8*)(ap + 16 * kk), b = *(const bf16x8*)(bp + 16 * kk);
                    acc = __builtin_amdgcn_mfma_f32_32x32x16_bf16(a, b, acc, 0, 0, 0); }
                LAS float* red = (LAS float*)L;
                __syncthreads();
#pragma unroll
                for (int i = 0; i < 16; ++i) red[(wave * 64 + lane) * 16 + i] = acc[i];
                __syncthreads();
#pragma unroll
                for (int q = 0; q < 2; ++q) { const int idx = tid + 512 * q, ln = idx >> 4, reg = idx & 15; float s = 0.f;
#pragma unroll
                    for (int w = 0; w < 8; ++w) s += red[(w * 64 + ln) * 16 + reg];
                    const int col = ln & 31, rowi = (reg & 3) + 8 * (reg >> 2) + 4 * (ln >> 5), row = 32 * rt + rowi;
                    const float val = s * pg8::rstd_of(ssq + M, row);
                    if (col < 16) BETA[row * 16 + col] = 1.0f / (1.0f + __expf(-val));
                    else { const int h = col - 16; const float z = val + args.in[9][h]; const float sp = fmaxf(z, 0.f) + log1pf(__expf(-fabsf(z)));
                        GLOG[row * 16 + h] = -__expf(args.in[8][h]) * sp; } }
            }
            __syncthreads();
        }
        pg8::Gemm g{XB, Win, M, NPROJ_MAIN, D, LDD, LDD}; pg8::StaticOrder S; S.init(M, NPROJ_MAIN, G, bx);
        pg8::EpiProj E{PROJ, ssq + M};
        pg8::gemm_phase<pg8::EpiProj, pg8::StaticOrder, true, true>(L, g, S, E, wave);
        if (BOTH(3)) GRID_BAR();
    }
    if (IN(4)) {
        REFRESH_IDS();
        { u32x4 xr[24]; float gpre, bpre; int sh0 = -1, sh1 = -1, it = 0;
          CL_PREFETCH(vcu);
          for (int unit = vcu; unit < 2048; unit += G, ++it) { const int nxt = unit + G < 2048 ? unit + G : unit;
              dn_chunk_local(unit, nxt, it & 1, sh0, sh1, xr, gpre, bpre, PROJ, args.in[7], GLOG, BETA, DNB, L, tid, lane, wave); } }
        if (BOTH(4)) GRID_BAR();
    }
    if (IN(5)) {
        REFRESH_IDS();
        if (vcu < 64) { dn_scan(vcu, DNB, ORAW, L, tid, lane, wave);
            REFRESH_IDS(); dn_gate_rows(vcu, ORAW, PROJ, args.in[10], CONCAT, lane, wave); REFRESH_IDS(); }
        { LAS float* scr = (LAS float*)(L + wave * (64 * 65 * 4));
          for (;;) {
            __syncthreads();
            if (tid == 0) MISC[16] = __hip_atomic_fetch_add(ctl + CW_AQ, 1u, __ATOMIC_RELAXED, __HIP_MEMORY_SCOPE_AGENT);
            __syncthreads();
            constexpr int NB64 = (NCB * 3) / 4, NB16 = (NCB - NB64) * 4;
            const unsigned q = MISC[16]; if (q >= 512u + (DEFER_AT == 5 ? (unsigned)(NB64 + NB16) : 0u)) break;
            REFRESH_IDS();
#if QORDER == 0
            const bool conv = DEFER_AT == 5 ? (q < 1024u ? (q & 1u) != 0u : true) : false; const int idx = DEFER_AT == 5 ? (q < 1024u ? (int)(q >> 1) : (int)(q - 512u)) : (int)q;
#elif QORDER == 1
            const bool conv = q >= 512u; const int idx = conv ? (int)(q - 512u) : (int)q;
#else
            const bool conv = q < (unsigned)NCB; const int idx = conv ? (int)q : (int)(q - (unsigned)NCB);
#endif
            if (!conv) attn_wg(PROJ, CONCAT, idx, L, tid, lane, wave);
            else {
                const bool small = idx >= NB64; const int first = NI0 + (small ? NB64 * 64 + (idx - NB64) * 16 : idx * 64) + wave;
                f32x4 va[16], vb[16]; P0T_DECL(a); P0T_DECL(b);
#define CV_LA(k) do { P0T_RESOLVE(a, first + 8 * (k)); p0_load(aW, aN, ak0, an0, lane, va); } while (0)
#define CV_LB(k) do { P0T_RESOLVE(b, first + 8 * (k)); p0_load(bW, bN, bk0, bn0, lane, vb); } while (0)
#define CV_FA() p0_finish(aT, aG, aN, ak0, an0, ald, ablk, aoff, lane, va, scr)
#define CV_FB() p0_finish(bT, bG, bN, bk0, bn0, bld, bblk, boff, lane, vb, scr)
                if (small) { CV_LA(0); CV_LB(1); CV_FA(); CV_FB(); }
                else { CV_LA(0); CV_LB(1); CV_FA(); CV_LA(2); CV_FB(); CV_LB(3); CV_FA(); CV_LA(4); CV_FB(); CV_LB(5); CV_FA(); CV_LA(6); CV_FB(); CV_LB(7); CV_FA(); CV_FB(); }
#undef CV_LA
#undef CV_LB
#undef CV_FA
#undef CV_FB
            }
          } }
        if (BOTH(5)) GRID_BAR();
    }
    if (IN(7)) {
        REFRESH_IDS();
        pg8::Gemm g{CONCAT, Wout, M, D, D, LDD, LDD}; pg8::StaticOrder S; S.init(M, D, G, bx);
        pg8::EpiResid<true> E{out, out, XB, ssq + 2 * M, 1.0f};
        pg8::gemm_phase<pg8::EpiResid<true>, pg8::StaticOrder, true, true>(L, g, S, E, wave);
        if (BOTH(7)) GRID_BAR();
    }
    if (IN(8)) {
        REFRESH_IDS();
        pg8::Gemm g{XB, Wgu2, M, 2 * FF, D, LDD, LDD}; pg8::StaticOrder S; S.init(M, 2 * FF, G, bx);
        pg8::EpiGateUp E{ACT, ssq + 2 * M};
        pg8::gemm_phase<pg8::EpiGateUp, pg8::StaticOrder, true, true>(L, g, S, E, wave);
        if (BOTH(8)) GRID_BAR();
    }
    if (IN(9)) {
        REFRESH_IDS();
        pg8::Gemm g{ACT, Wd2, M, D, FF, LDF, LDF}; pg8::StaticOrder S; S.init(M, D, G, bx);
        pg8::EpiResid<true, false> E{out, out, XB, ssq + 3 * M, 0.5f};
        pg8::gemm_phase<pg8::EpiResid<true, false>, pg8::StaticOrder, true, true>(L, g, S, E, wave);
        if (BOTH(9)) GRID_BAR();
    }
    if (IN(10)) {
        REFRESH_IDS();
        const float* fn = args.in[16];
        for (int row = gw; row < M; row += NGW) {
            const float rs = pg8::rstd_of(ssq + 3 * M, row);
            const u32x4* hr = (const u32x4*)(XB + (size_t)row * LDD) + lane; f32x4* orow = (f32x4*)(out + (size_t)row * D) + 2 * lane; const f32x4* gp = (const f32x4*)fn + 2 * lane;
#pragma unroll
            for (int j = 0; j < 8; ++j) { const u32x4 hv = hr[64 * j]; const f32x4 g0 = gp[128 * j], g1 = gp[128 * j + 1];
                f32x4 o0, o1; o0[0] = bf_lo(hv.x) * rs * g0[0]; o0[1] = bf_hi(hv.x) * rs * g0[1]; o0[2] = bf_lo(hv.y) * rs * g0[2]; o0[3] = bf_hi(hv.y) * rs * g0[3];
                o1[0] = bf_lo(hv.z) * rs * g1[0]; o1[1] = bf_hi(hv.z) * rs * g1[1]; o1[2] = bf_lo(hv.w) * rs * g1[2]; o1[3] = bf_hi(hv.w) * rs * g1[3];
                orow[128 * j] = o0; orow[128 * j + 1] = o1; }
        }
    }
#if PROBE_BARS
    for (int r = 0; r < PROBE_BARS; ++r) GRID_BAR();
#endif
#if PROBE_X
    if (IN(11)) {
        pg8::Gemm g{XB, Wgu1, M, 2 * FF, D, LDD, LDD}; pg8::StaticOrder S; S.init(M, 2 * FF, G, bx);
        pg8::EpiNull E{(float*)(ws + WS_ORAW)};
        pg8::gemm_phase<pg8::EpiNull, pg8::StaticOrder, true, true>(L, g, S, E, wave);
    }
    if (IN(12)) {
        pg8::Gemm g{XB, Wgu1, M, 2 * FF, D, LDD, LDD}; pg8::MaskOrder S; S.init(M, 2 * FF, G, bx); S.mm = 1; S.mn = 1;
        pg8::EpiNull E{(float*)(ws + WS_ORAW)};
        pg8::gemm_phase<pg8::EpiNull, pg8::MaskOrder, true, true>(L, g, S, E, wave);
    }
    if (IN(13)) {
        pg8::Gemm g{XB, Wgu1, M, 2 * FF, D, LDD, LDD}; pg8::StaticOrder S; S.init(M, 2 * FF, G, bx);
        pg8::EpiGateUp E{ACT, ssq};
        pg8::gemm_phase<pg8::EpiGateUp, pg8::StaticOrder, true, true>(L, g, S, E, wave);
    }
    if (IN(14)) {
        pg8::Gemm g{ACT, Wd1, M, D, FF, LDF, LDF}; pg8::StaticOrder S; S.init(M, D, G, bx);
        pg8::EpiNull E{(float*)(ws + WS_ORAW)};
        pg8::gemm_phase<pg8::EpiNull, pg8::StaticOrder, true, true>(L, g, S, E, wave);
    }
#endif
#undef P0_RUN
#undef P0T_RESOLVE
#undef P0T_SET
#undef IN
#undef BOTH
}

extern "C" void kernel_launch(void* const* d_in, const int* in_sizes, int n_in, void* d_out, int out_size, void* d_ws, size_t ws_size, hipStream_t stream) {
    static int grid = 0;
    if (grid == 0) {
        if (n_in != 17 || in_sizes[0] != M * D || out_size != M * D || ws_size < WS_END) { fprintf(stderr, "kernel_launch: unexpected shapes (n_in %d, in0 %d, out %d, ws %zu < %zu); nothing launched\n", n_in, n_in > 0 ? in_sizes[0] : -1, out_size, ws_size, (size_t)WS_END); grid = -1; return; }
        int dev = 0, cus = 0, per_cu = 0;
        if (hipGetDevice(&dev) != hipSuccess || hipDeviceGetAttribute(&cus, hipDeviceAttributeMultiprocessorCount, dev) != hipSuccess) { fprintf(stderr, "kernel_launch: device query failed\n"); grid = -1; return; }
        if (hipFuncSetAttribute((const void*)fwd, hipFuncAttributeMaxDynamicSharedMemorySize, LDS_BYTES) != hipSuccess) { fprintf(stderr, "kernel_launch: hipFuncSetAttribute failed\n"); grid = -1; return; }
        if (hipOccupancyMaxActiveBlocksPerMultiprocessor(&per_cu, (const void*)fwd, NWAVES * 64, LDS_BYTES) != hipSuccess || per_cu < 1) fprintf(stderr, "kernel_launch: note: occupancy query reports %d workgroups per CU\n", per_cu);
        (void)hipGetLastError();
        grid = cus;
    }
    if (grid < 0) return;
    if (hipMemsetAsync((char*)d_ws + WS_CTL, 0, CTL_ZERO_BYTES, stream) != hipSuccess) { fprintf(stderr, "kernel_launch: memset failed\n"); return; }
    Args a{};
    for (int i = 0; i < 17; ++i) a.in[i] = (const float*)d_in[i];
    a.out = (float*)d_out; a.ws = (unsigned char*)d_ws;
#if ONE_LAUNCH
    a.ph_lo = 0; a.ph_hi = NPH;
    hipLaunchKernelGGL(fwd, dim3(grid), dim3(NWAVES * 64), LDS_BYTES, stream, a);
#else
    for (int k = 0; k < NPH; ++k) { a.ph_lo = k; a.ph_hi = k + 1; for (int r = 0; r < (k == PROBE_REP ? 2 : 1); ++r) { if (r == 1 && PROBE_RESETQ) (void)hipMemsetAsync((char*)d_ws + CW_AQ * 4, 0, 4, stream); hipLaunchKernelGGL(fwd, dim3(grid), dim3(NWAVES * 64), LDS_BYTES, stream, a); } }
#endif
#if PROBE_X
    a.ph_lo = 10 + PROBE_X; a.ph_hi = 11 + PROBE_X; hipLaunchKernelGGL(fwd, dim3(grid), dim3(NWAVES * 64), LDS_BYTES, stream, a);
#endif
    const hipError_t le = hipPeekAtLastError();
    if (le != hipSuccess) fprintf(stderr, "kernel_launch: launch failed: %s\n", hipGetErrorName(le));
}
```
